# Optimizing an MI355X kernel written in HIP

```python
import math
import jax, jax.numpy as jnp
from jax import lax
import numpy as np

D_MODEL = 1024
BATCH = 8
SEQ = 4096
DEPTH = 1

MIX_WIDTH = D_MODEL
ATTN_WIDTH = D_MODEL // 2
HGRN_WIDTH = MIX_WIDTH - ATTN_WIDTH
DIFF_HEADS = 4
DIFF_VDIM = ATTN_WIDTH // DIFF_HEADS
DIFF_QK = DIFF_VDIM // 2
Q_BLOCK = 128
HGRN_HEADS = 4
HGRN_DIM = HGRN_WIDTH // HGRN_HEADS
HGRN_CHUNK = 64
PEER_HEADS = 8
N_KEYS = 128
N_EXPERTS = N_KEYS * N_KEYS
PEER_TOPK = 16
PEER_QDIM = 256
PEER_QHALF = PEER_QDIM // 2
PEER_TOKEN_BLOCK = 128
N_MOD = 6
EPS = 1e-6
SPLIT_SIZES = [DIFF_HEADS * 2 * DIFF_QK, DIFF_HEADS * 2 * DIFF_QK, ATTN_WIDTH,
               HGRN_WIDTH, HGRN_WIDTH, HGRN_WIDTH, HGRN_WIDTH]
IN_COLS = sum(SPLIT_SIZES)
SPLIT_POINTS = [int(v) for v in np.cumsum(SPLIT_SIZES)[:-1]]

kernel_name = "hybrid_diffattn_hgrn2_peer_block"


def rmsnorm(x, g):
    xf = x.astype(jnp.float32)
    y = xf * lax.rsqrt(jnp.mean(xf * xf, axis=-1, keepdims=True) + EPS)
    return (y * g.astype(jnp.float32)).astype(x.dtype)


def diff_attention(q, k, v, lam):
    B, H, _, S, d = q.shape
    nblk = S // Q_BLOCK
    scale = 1.0 / math.sqrt(d)
    qb = q.reshape(B, H, 2, nblk, Q_BLOCK, d).transpose(3, 0, 1, 2, 4, 5)
    kpos = jnp.arange(S)
    vf = v.astype(jnp.float32)

    def one_block(args):
        qi, i = args
        s = jnp.einsum('bhjqd,bhjkd->bhjqk', qi, k).astype(jnp.float32) * scale
        qpos = i * Q_BLOCK + jnp.arange(Q_BLOCK)
        mask = kpos[None, :] <= qpos[:, None]
        s = jnp.where(mask, s, -jnp.inf)
        p = jax.nn.softmax(s, axis=-1)
        a = p[:, :, 0] - lam * p[:, :, 1]
        return jnp.einsum('bhqk,bhkv->bhqv', a, vf)

    out = lax.map(one_block, (qb, jnp.arange(nblk)))
    return out.transpose(1, 2, 0, 3, 4).reshape(B, H, S, v.shape[-1])


def hgrn2_chunkwise(q, k, v, logf):
    B, H, S, dk = q.shape
    dv = v.shape[-1]
    C = HGRN_CHUNK
    n = S // C

    def to_chunks(t):
        return t.reshape(B, H, n, C, t.shape[-1]).transpose(2, 0, 1, 3, 4)

    qc, kc, vc, gc = to_chunks(q), to_chunks(k), to_chunks(v.astype(jnp.float32)), to_chunks(logf)
    bc = jnp.cumsum(gc, axis=-2)
    causal = jnp.tril(jnp.ones((C, C), dtype=bool))[..., None]

    def step(state, inp):
        q_, k_, v_, b_ = inp
        diff = b_[..., :, None, :] - b_[..., None, :, :]
        decay = jnp.exp(jnp.where(causal, diff, -jnp.inf))
        attn = jnp.einsum('bhtk,bhtsk,bhsk->bhts', q_, decay, k_)
        o_intra = jnp.einsum('bhts,bhsv->bhtv', attn, v_)
        o_inter = jnp.einsum('bhtk,bhkv->bhtv', q_ * jnp.exp(b_), state)
        b_last = b_[..., -1:, :]
        new_state = (jnp.exp(b_last[..., 0, :])[..., None] * state
                     + jnp.einsum('bhsk,bhsv->bhkv', k_ * jnp.exp(b_last - b_), v_))
        return new_state, o_intra + o_inter

    state0 = jnp.zeros((B, H, dk, dv), jnp.float32)
    _, ys = lax.scan(step, state0, (qc, kc, vc, bc))
    return ys.transpose(1, 2, 0, 3, 4).reshape(B, H, S, dv)


def hybrid_mixer(h, w_in, lam_qk, g_diff_sub, lb, g_hgrn_out, w_out, lam_init):
    B, S, _ = h.shape
    proj = h @ w_in
    aq, ak, av, hq, hf, hi, hg = jnp.split(proj, SPLIT_POINTS, axis=-1)

    aq = aq.reshape(B, S, DIFF_HEADS, 2, DIFF_QK).transpose(0, 2, 3, 1, 4)
    ak = ak.reshape(B, S, DIFF_HEADS, 2, DIFF_QK).transpose(0, 2, 3, 1, 4)
    av = av.reshape(B, S, DIFF_HEADS, DIFF_VDIM).transpose(0, 2, 1, 3)
    lq = lam_qk.astype(jnp.float32)
    lam = jnp.exp(jnp.sum(lq[0] * lq[1])) - jnp.exp(jnp.sum(lq[2] * lq[3])) + lam_init
    ao = diff_attention(aq, ak, av, lam)
    ao = rmsnorm(ao, g_diff_sub) * (1.0 - lam_init)
    ao = ao.transpose(0, 2, 1, 3).reshape(B, S, ATTN_WIDTH)

    def heads(t):
        return t.reshape(B, S, HGRN_HEADS, HGRN_DIM).transpose(0, 2, 1, 3)
    lbf = lb.astype(jnp.float32)
    f = lbf + (1.0 - lbf) * jax.nn.sigmoid(hf.astype(jnp.float32))
    logf = jnp.log(f)
    kk = 1.0 - f
    qh = jax.nn.silu(hq.astype(jnp.float32))
    ho = hgrn2_chunkwise(heads(qh), heads(kk), heads(hi), heads(logf))
    ho = rmsnorm(ho, g_hgrn_out).transpose(0, 2, 1, 3).reshape(B, S, HGRN_WIDTH)
    ho = ho * jax.nn.silu(hg.astype(jnp.float32))

    cat = jnp.concatenate([ao.astype(jnp.float32), ho], axis=-1).astype(h.dtype)
    return cat @ w_out


def peer(h, w_pq, sub_keys, expert_u, expert_v):
    B, S, D = h.shape
    q = (h @ w_pq).reshape(B, S, PEER_HEADS, 2, PEER_QHALF)
    s = jnp.einsum('bshjd,hjnd->bshjn', q, sub_keys).astype(jnp.float32)
    v1, i1 = lax.top_k(s[..., 0, :], PEER_TOPK)
    v2, i2 = lax.top_k(s[..., 1, :], PEER_TOPK)
    cand = (v1[..., :, None] + v2[..., None, :]).reshape(B, S, PEER_HEADS, PEER_TOPK * PEER_TOPK)
    cidx = (i1[..., :, None] * N_KEYS + i2[..., None, :]).reshape(B, S, PEER_HEADS, PEER_TOPK * PEER_TOPK)
    top_s, pos = lax.top_k(cand, PEER_TOPK)
    idx = jnp.take_along_axis(cidx, pos, axis=-1)
    gate = jax.nn.softmax(top_s, axis=-1)

    T = B * S
    nb = T // PEER_TOKEN_BLOCK
    hb_all = h.reshape(nb, PEER_TOKEN_BLOCK, D)
    ib_all = idx.reshape(nb, PEER_TOKEN_BLOCK, PEER_HEADS * PEER_TOPK)
    gb_all = gate.reshape(nb, PEER_TOKEN_BLOCK, PEER_HEADS * PEER_TOPK)

    def one_block(args):
        hb, ib, gb = args
        u = jnp.take(expert_u, ib, axis=0)
        a = jnp.einsum('tkd,td->tk', u, hb).astype(jnp.float32)
        w = gb * jax.nn.gelu(a, approximate=False)
        vsel = jnp.take(expert_v, ib, axis=0)
        return jnp.einsum('tk,tkd->td', w.astype(vsel.dtype), vsel)

    out = lax.map(one_block, (hb_all, ib_all, gb_all))
    return out.reshape(B, S, D)


def setup_inputs(seed: int = 0) -> dict:
    key = jax.random.key(seed)
    ks = jax.random.split(key, 20)
    f32 = jnp.float32
    D = D_MODEL
    nrm = lambda k, shp, s: jax.random.normal(k, shp, f32) * s
    gain = lambda k, shp: 1.0 + 0.02 * jax.random.normal(k, shp, f32)
    return {
        "x": nrm(ks[0], (BATCH, SEQ, D), 1.0),
        "c": nrm(ks[1], (BATCH, D), 1.0),
        "w_ada": nrm(ks[2], (DEPTH, D, N_MOD * D), 0.5 * D ** -0.5),
        "b_ada": nrm(ks[3], (DEPTH, N_MOD * D), 0.02),
        "g_pre_mix": gain(ks[4], (DEPTH, D)),
        "g_post_mix": gain(ks[5], (DEPTH, D)),
        "g_pre_ffn": gain(ks[6], (DEPTH, D)),
        "g_post_ffn": gain(ks[7], (DEPTH, D)),
        "w_in": nrm(ks[8], (DEPTH, D, IN_COLS), D ** -0.5),
        "lam_qk": nrm(ks[9], (DEPTH, 4, DIFF_QK), 0.1),
        "g_diff_sub": gain(ks[10], (DEPTH, DIFF_VDIM)),
        "lb_theta": nrm(ks[11], (DEPTH + 1, HGRN_WIDTH), 0.1),
        "g_hgrn_out": gain(ks[12], (DEPTH, HGRN_DIM)),
        "w_out": nrm(ks[13], (DEPTH, MIX_WIDTH, D), MIX_WIDTH ** -0.5),
        "w_pq": nrm(ks[14], (DEPTH, D, PEER_HEADS * PEER_QDIM), D ** -0.5),
        "sub_keys": nrm(ks[15], (DEPTH, PEER_HEADS, 2, N_KEYS, PEER_QHALF), PEER_QHALF ** -0.5),
        "expert_u": nrm(ks[16], (DEPTH, N_EXPERTS, D), D ** -0.5),
        "expert_v": nrm(ks[17], (DEPTH, N_EXPERTS, D), D ** -0.5),
    }


def reference(x, c, w_ada, b_ada, g_pre_mix, g_post_mix, g_pre_ffn, g_post_ffn, w_in, lam_qk,
              g_diff_sub, lb_theta, g_hgrn_out, w_out, w_pq, sub_keys, expert_u, expert_v):
    lb_all = jnp.cumsum(jax.nn.softmax(lb_theta.astype(jnp.float32), axis=0), axis=0)
    c_act = jax.nn.silu(c)
    for l in range(DEPTH):
        lam_init = 0.8 - 0.6 * math.exp(-0.3 * l)
        mod = (c_act @ w_ada[l] + b_ada[l])[:, None, :]
        sh1, sc1, gt1, sh2, sc2, gt2 = jnp.split(mod, N_MOD, axis=-1)
        h = rmsnorm(x, g_pre_mix[l]) * (1.0 + sc1) + sh1
        y = hybrid_mixer(h, w_in[l], lam_qk[l], g_diff_sub[l], lb_all[l], g_hgrn_out[l], w_out[l], lam_init)
        x = x + gt1 * rmsnorm(y, g_post_mix[l])
        h = rmsnorm(x, g_pre_ffn[l]) * (1.0 + sc2) + sh2
        y = peer(h, w_pq[l], sub_keys[l], expert_u[l], expert_v[l])
        x = x + gt2 * rmsnorm(y, g_post_ffn[l])
    return x
```

```cpp
#include <hip/hip_runtime.h>
#include <cstdio>
#include <cstdint>

#define GAS __attribute__((address_space(1)))
#define LAS __attribute__((address_space(3)))
typedef unsigned short bf16;
typedef unsigned v4u __attribute__((ext_vector_type(4)));
typedef unsigned v2u __attribute__((ext_vector_type(2)));
typedef float f32x4 __attribute__((ext_vector_type(4)));
typedef float f32x16 __attribute__((ext_vector_type(16)));
typedef short bf16x8 __attribute__((ext_vector_type(8)));
typedef short s16x4 __attribute__((ext_vector_type(4)));
typedef GAS unsigned gu32;
#define RLX_AGENT __ATOMIC_RELAXED, __HIP_MEMORY_SCOPE_AGENT
#define LDS_WAIT() asm volatile("s_waitcnt lgkmcnt(0)" ::: "memory")
#define VM_WAIT() asm volatile("s_waitcnt vmcnt(0)" ::: "memory")

constexpr int D = 1024, NB = 8, S = 4096, T = NB * S;
constexpr int INC = 3584, NMOD = 6 * D, NEXP = 16384, NPQ = 2048;
constexpr float EPS = 1e-6f, LAM_INIT = 0.2f;
constexpr float LOG2E = 1.4426950408889634f;
constexpr float QSCALE = 0.125f * LOG2E;
constexpr int C_AQ = 0, C_AK = 512, C_AV = 1024, C_HQ = 1536, C_HF = 2048, C_HI = 2560, C_HG = 3072;
constexpr int NWAVES = 8;

constexpr size_t MiB = 1u << 20;
constexpr size_t WS_CTL = 0, CTL_ZERO_BYTES = 1 * MiB;
constexpr size_t WS_MOD = 1 * MiB;
constexpr size_t WS_MISC = 1 * MiB + 256 * 1024;
constexpr size_t WS_WIN = 2 * MiB, WS_WOUT = 9 * MiB, WS_WPQ = 11 * MiB, WS_KEYS = 15 * MiB;
constexpr size_t WS_HD = 16 * MiB;
constexpr size_t WS_EU8 = 17 * MiB, WS_EV8 = 33 * MiB;
constexpr size_t WS_SU = 49 * MiB, WS_SV = 49 * MiB + 512 * 1024;
constexpr size_t WS_H8 = 50 * MiB, WS_HS = 82 * MiB;
constexpr size_t WS_H = 96 * MiB;
constexpr size_t WS_P = 160 * MiB;
constexpr size_t PSTRIDE = (size_t)T * 512;
constexpr size_t WS_CAT = 384 * MiB;
constexpr size_t WS_Y = 160 * MiB;
constexpr size_t WS_Q = 224 * MiB;
constexpr size_t WS_PIDX = 352 * MiB, WS_PGATE = 368 * MiB;
constexpr size_t WS_LSC = 448 * MiB, WS_DSC = 464 * MiB;
constexpr size_t WS_Y2 = 224 * MiB;
constexpr size_t WS_RS = 83 * MiB;
constexpr size_t WS_CS2 = 512 * 1024 + 16384;
constexpr size_t WS_CS = 512 * 1024;
constexpr size_t WS_R1 = 82 * MiB + 256 * 1024;
constexpr size_t WS_X1 = 384 * MiB;
constexpr size_t WS_X1B = 96 * MiB;
constexpr size_t WS_END = 512 * MiB;
constexpr int CW_TMO = 0, CW_BAR = 4096;

__device__ __forceinline__ unsigned f2bf(float f) { unsigned u = __builtin_bit_cast(unsigned, f); return (u + 0x7fffu + ((u >> 16) & 1u)) >> 16; }
__device__ __forceinline__ unsigned pk2(float lo, float hi) { unsigned r; asm("v_cvt_pk_bf16_f32 %0, %1, %2" : "=v"(r) : "v"(lo), "v"(hi)); return r; }
__device__ __forceinline__ float bf2f(unsigned short h) { return __builtin_bit_cast(float, (unsigned)h << 16); }
__device__ __forceinline__ float bflo(unsigned w) { return __builtin_bit_cast(float, w << 16); }
__device__ __forceinline__ float bfhi(unsigned w) { return __builtin_bit_cast(float, w & 0xffff0000u); }
__device__ __forceinline__ float wave_sum(float v) {
#pragma unroll
    for (int o = 1; o < 64; o <<= 1) v += __shfl_xor(v, o);
    return v;
}
__device__ __forceinline__ float wave_sum_fast(float v) {
    v += __builtin_bit_cast(float, __builtin_amdgcn_update_dpp(0, __builtin_bit_cast(int, v), 0xB1, 0xf, 0xf, true));
    v += __builtin_bit_cast(float, __builtin_amdgcn_update_dpp(0, __builtin_bit_cast(int, v), 0x4E, 0xf, 0xf, true));
    v += __builtin_bit_cast(float, __builtin_amdgcn_update_dpp(0, __builtin_bit_cast(int, v), 0x141, 0xf, 0xf, true));
    v += __builtin_bit_cast(float, __builtin_amdgcn_update_dpp(0, __builtin_bit_cast(int, v), 0x140, 0xf, 0xf, true));
    const int i = __builtin_bit_cast(int, v);
    return (__builtin_bit_cast(float, __builtin_amdgcn_readlane(i, 0)) + __builtin_bit_cast(float, __builtin_amdgcn_readlane(i, 16))) +
           (__builtin_bit_cast(float, __builtin_amdgcn_readlane(i, 32)) + __builtin_bit_cast(float, __builtin_amdgcn_readlane(i, 48)));
}
__device__ __forceinline__ float wave_max_fast(float v) {
    v = fmaxf(v, __builtin_bit_cast(float, __builtin_amdgcn_update_dpp(0, __builtin_bit_cast(int, v), 0xB1, 0xf, 0xf, true)));
    v = fmaxf(v, __builtin_bit_cast(float, __builtin_amdgcn_update_dpp(0, __builtin_bit_cast(int, v), 0x4E, 0xf, 0xf, true)));
    v = fmaxf(v, __builtin_bit_cast(float, __builtin_amdgcn_update_dpp(0, __builtin_bit_cast(int, v), 0x141, 0xf, 0xf, true)));
    v = fmaxf(v, __builtin_bit_cast(float, __builtin_amdgcn_update_dpp(0, __builtin_bit_cast(int, v), 0x140, 0xf, 0xf, true)));
    const int i = __builtin_bit_cast(int, v);
    return fmaxf(fmaxf(__builtin_bit_cast(float, __builtin_amdgcn_readlane(i, 0)), __builtin_bit_cast(float, __builtin_amdgcn_readlane(i, 16))),
                 fmaxf(__builtin_bit_cast(float, __builtin_amdgcn_readlane(i, 32)), __builtin_bit_cast(float, __builtin_amdgcn_readlane(i, 48))));
}
__device__ __forceinline__ float siluf(float x) { return x * __builtin_amdgcn_rcpf(1.f + __expf(-x)); }
__device__ __forceinline__ float sigmf(float x) { return __builtin_amdgcn_rcpf(1.f + __expf(-x)); }
template <int CTRL> __device__ __forceinline__ float dpp_one(float v) { return __builtin_bit_cast(float, __builtin_amdgcn_update_dpp(0x3f800000, __builtin_bit_cast(int, v), CTRL, 0xf, 0xf, false)); }
typedef float f32x2 __attribute__((ext_vector_type(2)));
template <int CTRL> __device__ __forceinline__ float dpp_f(float v) { return __builtin_bit_cast(float, __builtin_amdgcn_update_dpp(0, __builtin_bit_cast(int, v), CTRL, 0xf, 0xf, true)); }

__device__ __forceinline__ void glds16(const void* gsrc, unsigned lds_dst) { unsigned keep;
    asm volatile("s_mov_b32 %0, m0\n\ts_mov_b32 m0, %2\n\ts_nop 0\n\tglobal_load_lds_dwordx4 %1, off\n\ts_mov_b32 m0, %0" : "=&s"(keep) : "v"(gsrc), "s"(lds_dst) : "memory"); }
__device__ __forceinline__ unsigned lds_addr(LAS const void* p) { return (unsigned)__builtin_amdgcn_readfirstlane((int)(unsigned)(size_t)p); }
#define XB_TMO      128
#define XB_XCNT(j)  (256  + 64 * (j))
#define XB_XSUB(j)  (1280 + 64 * (j))
#define XB_XGEN(j)  (2304 + 64 * (j))
#define XB_TOP      3328
#define XB_TOPGEN   3392
#define XCD_BAR_WORDS 3456
#define XB_SPIN_CAP (1u << 18)
__device__ __forceinline__ unsigned xb_ld(unsigned* p)              { return __hip_atomic_load(p, __ATOMIC_RELAXED, __HIP_MEMORY_SCOPE_AGENT); }
__device__ __forceinline__ unsigned xb_add(unsigned* p, unsigned v) { return __hip_atomic_fetch_add(p, v, __ATOMIC_RELAXED, __HIP_MEMORY_SCOPE_AGENT); }
__device__ __forceinline__ unsigned xb_xcc_id() { return (unsigned)__builtin_amdgcn_s_getreg((3 << 11) | 20) & 0xFu; }
#define XB_SPIN(cond, bar) do { unsigned _sp = 0; while (cond) { __builtin_amdgcn_s_sleep(1); \
    if ((++_sp & 255u) == 0u) { if (xb_ld(&(bar)[XB_TMO])) break; if (_sp > XB_SPIN_CAP) { atomicAdd(&(bar)[XB_TMO], 1u); break; } } } } while (0)
struct XcdBarrier { unsigned* bar; unsigned x; volatile LAS unsigned* st; };
__device__ __forceinline__ XcdBarrier xcd_barrier_post(unsigned* bar, volatile LAS unsigned* st) {
    XcdBarrier b; b.bar = bar; b.x = xb_xcc_id(); b.st = st;
    if (threadIdx.x == 0) (void)xb_add(&bar[XB_XCNT(b.x)], 1u);
    return b;
}
__device__ __forceinline__ void xcd_barrier_complete(unsigned* bar, unsigned x, unsigned& nloc, unsigned& nx) {
    const unsigned G = gridDim.x * gridDim.y * gridDim.z;
    unsigned sum, cnt, mine, sp = 0u;
    for (;;) {
        sum = 0u; cnt = 0u; mine = 0u;
#pragma unroll
        for (unsigned j = 0; j < 16; ++j) { const unsigned c = xb_ld(&bar[XB_XCNT(j)]); sum += c; cnt += (c > 0u) ? 1u : 0u; mine = (j == x) ? c : mine; }
        if (sum == G) break;
        __builtin_amdgcn_s_sleep(1);
        if ((++sp & 255u) == 0u) { if (xb_ld(&bar[XB_TMO])) break; if (sp > XB_SPIN_CAP) { atomicAdd(&bar[XB_TMO], 1u); break; } }
    }
    nloc = mine > 0u ? mine : 1u; nx = cnt > 0u ? cnt : 1u;
}
__device__ __forceinline__ void xcd_barrier(const XcdBarrier& b) {
    asm volatile("s_waitcnt vmcnt(0)" ::: "memory");
    __syncthreads();
    if (threadIdx.x == 0) {
        unsigned* bar = b.bar;
        __builtin_amdgcn_s_waitcnt(0);
        unsigned nloc = b.st[0], nx = b.st[1];
        if (nloc == 0u) { xcd_barrier_complete(bar, b.x, nloc, nx); b.st[0] = nloc; b.st[1] = nx; }
        const unsigned old = xb_add(&bar[XB_XSUB(b.x)], 1u);
        const unsigned gen = old / nloc;
        if (old + 1u == (gen + 1u) * nloc) {
            __builtin_amdgcn_fence(__ATOMIC_RELEASE, "agent");
            asm volatile("s_waitcnt vmcnt(0)" ::: "memory");
            const unsigned og = xb_add(&bar[XB_TOP], 1u);
            const unsigned tg = og / nx;
            if (og + 1u == (tg + 1u) * nx) xb_add(&bar[XB_TOPGEN], 1u);
            else XB_SPIN(xb_ld(&bar[XB_TOPGEN]) == tg, bar);
            __builtin_amdgcn_fence(__ATOMIC_ACQUIRE, "agent");
            xb_add(&bar[XB_XGEN(b.x)], 1u);
            asm volatile("s_waitcnt vmcnt(0)" ::: "memory");
        } else {
            XB_SPIN(xb_ld(&bar[XB_XGEN(b.x)]) == gen, bar);
            __builtin_amdgcn_fence(__ATOMIC_ACQUIRE, "agent");
            asm volatile("s_waitcnt vmcnt(0)" ::: "memory");
        }
    }
    __syncthreads();
}
namespace pg8 {
#define PG8_LAS __attribute__((address_space(3)))
typedef unsigned short bf16_t;
typedef short bf16x8 __attribute__((ext_vector_type(8)));
typedef float f32x4 __attribute__((ext_vector_type(4)));
typedef unsigned u32x4 __attribute__((ext_vector_type(4)));
constexpr int SCL_OFF = 131072 + 8192;
constexpr int BM = 256, BK = 64, HALF = 128, HTB = HALF * BK * 2, STAGE_BYTES = 8 * HTB, NXCD = 8, WGM = 8;

__host__ __device__ __forceinline__ int lds_byte(int r, int c) { const int st = (r >> 4) * 2 + (c >> 5), rr = r & 15, cc = c & 31, ob = rr * 64 + cc * 2; return st * 1024 + (ob ^ (((ob >> 9) & 1) << 5)); }
__host__ __device__ __forceinline__ void stage_rc(int b, int& R, int& C) { const int st = b / 1024, sb = b % 1024, swz = sb ^ (((sb >> 9) & 1) << 5); R = (st >> 1) * 16 + swz / 64; C = (st & 1) * 32 + (swz % 64) / 2; }
__host__ __device__ __forceinline__ int perm32(int rho) { const int n = rho >> 4, i = rho & 15; return 8 * (i >> 2) + 4 * n + (i & 3); }

struct Unit { int pm, pn; };
struct Gemm { const bf16_t* A; const bf16_t* Bt; int M, N, K; };

struct StaticOrder {
    int nM, nN, nwg, G, c;
    __host__ __device__ void init(int M, int N, int G_, int c_) { nM = M / BM; nN = N / BM; nwg = nM * nN; G = G_; c = c_; }
    __host__ __device__ bool next(int i, Unit& u) const {
        const long L = (long)i * G + c; if (L >= nwg) return false;
        int wgid = (int)L; { const int q = nwg / NXCD, r = nwg % NXCD, xcd = wgid % NXCD, off = wgid / NXCD; wgid = (xcd < r ? xcd * (q + 1) : r * (q + 1) + (xcd - r) * q) + off; }
        const int nig = WGM * nN, gid = wgid / nig, fm = gid * WGM, gsz = (nM - fm) < WGM ? (nM - fm) : WGM;
        u.pm = fm + ((wgid % nig) % gsz); u.pn = (wgid % nig) / gsz; return true;
    }
    __device__ __forceinline__ void a_ready(const Unit&) const {}
    __device__ __forceinline__ void done(const Unit&) const {}
};

__device__ __forceinline__ unsigned cvt_pk_bf16(float lo, float hi) { unsigned r; asm volatile("v_cvt_pk_bf16_f32 %0, %1, %2" : "=v"(r) : "v"(lo), "v"(hi)); return r; }

typedef int i32x4 __attribute__((ext_vector_type(4)));
template <class Epi, class Sched, bool ALIGN_EPI = false, bool SP2 = false, bool I8 = false>
__device__ __forceinline__ void gemm_phase(PG8_LAS unsigned char* lds, const Gemm g, const Sched& S, const Epi& E) {
    const int tid = threadIdx.x, wid = __builtin_amdgcn_readfirstlane(tid >> 6), lane = tid & 63, wr = wid >> 2, wc = wid & 3, fr = lane & 15, fq = lane >> 4;
    const int K = g.K, nt = K / BK;
    unsigned voffA[2], voffB[2];
#pragma unroll
    for (int i = 0; i < 2; ++i) { int R, C; stage_rc(tid * 16 + i * 8192, R, C); const int Rb = Epi::PERM ? ((R & ~31) + perm32(R & 31)) : R;
        voffA[i] = (unsigned)(R * K + C) * 2u; voffB[i] = (unsigned)(Rb * K + C) * 2u; }
    const size_t kstep = (size_t)(BK * 2);
    const size_t hstep = (size_t)HALF * K * 2;
    const size_t tstep = 2 * hstep;
    const unsigned ldsw = (unsigned)wid * 1024u;
    const int aoff = lds_byte(wr * 64 + fr, fq * 8), boff = lds_byte(wc * 32 + fr, fq * 8);
#define PG8_SA(b, h) (((b) * 2 + (h)) * HTB)
#define PG8_SB(b, h) ((4 + (b) * 2 + (h)) * HTB)
#define PG8_STAGE(bufoff, gbase, voff) do { _Pragma("unroll") for (int _i = 0; _i < 2; ++_i) \
        __builtin_amdgcn_global_load_lds((const unsigned*)((const char*)(gbase) + (voff)[_i]), (PG8_LAS unsigned*)(lds + (bufoff) + ldsw + _i * 8192), 16, 0, 0); } while (0)
#define PG8_LDA(dst, b, h) do { _Pragma("unroll") for (int m = 0; m < 4; ++m) _Pragma("unroll") for (int k = 0; k < 2; ++k) dst[m][k] = *(const PG8_LAS bf16x8*)(lds + PG8_SA(b, h) + aoff + m * 2048 + k * 1024); } while (0)
#define PG8_LDB(dst, b, h) do { _Pragma("unroll") for (int n = 0; n < 2; ++n) _Pragma("unroll") for (int k = 0; k < 2; ++k) dst[n][k] = *(const PG8_LAS bf16x8*)(lds + PG8_SB(b, h) + boff + n * 2048 + k * 1024); } while (0)
#define PG8_MMA(ai, bj, At, Bt) do { __builtin_amdgcn_s_setprio(1); _Pragma("unroll") for (int m = 0; m < 4; ++m) _Pragma("unroll") for (int n = 0; n < 2; ++n) _Pragma("unroll") for (int k = 0; k < 2; ++k) \
        { if constexpr (I8) acc[ai][bj][m][n] = __builtin_bit_cast(f32x4, __builtin_amdgcn_mfma_i32_16x16x64_i8(__builtin_bit_cast(i32x4, Bt[n][k]), __builtin_bit_cast(i32x4, At[m][k]), __builtin_bit_cast(i32x4, acc[ai][bj][m][n]), 0, 0, 0)); \
          else acc[ai][bj][m][n] = __builtin_amdgcn_mfma_f32_16x16x32_bf16(Bt[n][k], At[m][k], acc[ai][bj][m][n], 0, 0, 0); } __builtin_amdgcn_s_setprio(0); } while (0)
#define PG8_WAIT_V(n) asm volatile("s_waitcnt vmcnt(" #n ")" ::: "memory")
#define PG8_WAIT_L(n) asm volatile("s_waitcnt lgkmcnt(" #n ")" ::: "memory")
#define PG8_BAR __builtin_amdgcn_s_barrier()
#define PG8_SCHED __builtin_amdgcn_sched_barrier(0)
    Unit cur, nxt; int ui = 0;
    if (!S.next(0, cur)) return;
    f32x4 acc[2][2][4][2];
#pragma unroll
    for (int a = 0; a < 2; ++a)
#pragma unroll
        for (int b = 0; b < 2; ++b)
#pragma unroll
            for (int m = 0; m < 4; ++m)
#pragma unroll
                for (int n = 0; n < 2; ++n) acc[a][b][m][n] = (f32x4){0.f, 0.f, 0.f, 0.f};
    bf16x8 At[4][2], B0[2][2], B1[2][2];
    const char* cA = (const char*)g.A + (size_t)cur.pm * tstep; const char* cB = (const char*)g.Bt + (size_t)cur.pn * tstep;
    S.a_ready(cur);
    if constexpr (SP2) {
        PG8_STAGE(PG8_SB(0, 0), cB, voffB); PG8_STAGE(PG8_SB(0, 1), cB + hstep, voffB); PG8_STAGE(PG8_SA(0, 0), cA, voffA); PG8_STAGE(PG8_SA(0, 1), cA + hstep, voffA);
        if (wr == 1) PG8_BAR;
        PG8_WAIT_V(2); PG8_BAR;
        PG8_STAGE(PG8_SB(1, 0), cB + kstep, voffB); PG8_STAGE(PG8_SA(1, 0), cA + kstep, voffA); PG8_STAGE(PG8_SB(1, 1), cB + hstep + kstep, voffB);
        PG8_WAIT_V(6); PG8_BAR;
    } else {
        PG8_STAGE(PG8_SB(0, 0), cB, voffB); PG8_STAGE(PG8_SA(0, 0), cA, voffA); PG8_STAGE(PG8_SB(0, 1), cB + hstep, voffB); PG8_STAGE(PG8_SA(0, 1), cA + hstep, voffA);
        if (wr == 1) PG8_BAR;
        PG8_WAIT_V(4); PG8_BAR;
        PG8_STAGE(PG8_SB(1, 0), cB + kstep, voffB); PG8_STAGE(PG8_SA(1, 0), cA + kstep, voffA); PG8_STAGE(PG8_SB(1, 1), cB + hstep + kstep, voffB);
        PG8_WAIT_V(6); PG8_BAR;
    }
    if constexpr (Epi::LDS_SCALE) __builtin_amdgcn_global_load_lds((const unsigned*)(E.scale_base(cur, wid) + lane), (PG8_LAS unsigned*)(lds + SCL_OFF + wid * 256), 4, 0, 0);
    for (;;) {
        const bool has_next = S.next(ui + 1, nxt);
        const char* nA = has_next ? (const char*)g.A + (size_t)nxt.pm * tstep : cA; const char* nB = has_next ? (const char*)g.Bt + (size_t)nxt.pn * tstep : cB;
        for (int t = 0; t < nt; t += 2) {
            const bool last = (t == nt - 2);
            const char* a1 = cA + (size_t)(t + 1) * kstep;
            const char* a2 = last ? nA : cA + (size_t)(t + 2) * kstep; const char* b2 = last ? nB : cB + (size_t)(t + 2) * kstep;
            const char* a3 = a2 + kstep; const char* b3 = b2 + kstep;
            if (last && has_next) S.a_ready(nxt);
            if constexpr (SP2) {
            PG8_LDB(B0, 0, 0); PG8_LDB(B1, 0, 1); PG8_SCHED; PG8_LDA(At, 0, 0); PG8_STAGE(PG8_SA(1, 1), a1 + hstep, voffA);
            PG8_WAIT_V(8); PG8_WAIT_L(0); PG8_BAR;
            PG8_MMA(0, 0, At, B0); PG8_MMA(0, 1, At, B1); PG8_BAR; PG8_SCHED;
            PG8_LDA(At, 0, 1); PG8_STAGE(PG8_SB(0, 0), b2, voffB); PG8_STAGE(PG8_SB(0, 1), b2 + hstep, voffB); PG8_STAGE(PG8_SA(0, 0), a2, voffA);
            PG8_WAIT_V(8); PG8_WAIT_L(0); PG8_BAR; PG8_MMA(1, 0, At, B0); PG8_MMA(1, 1, At, B1); PG8_BAR; PG8_SCHED;
            PG8_LDB(B0, 1, 0); PG8_LDB(B1, 1, 1); PG8_SCHED; PG8_LDA(At, 1, 0); PG8_STAGE(PG8_SA(0, 1), a2 + hstep, voffA);
            PG8_WAIT_V(8); PG8_WAIT_L(0); PG8_BAR; PG8_MMA(0, 0, At, B0); PG8_MMA(0, 1, At, B1); PG8_BAR; PG8_SCHED;
            PG8_LDA(At, 1, 1); PG8_STAGE(PG8_SB(1, 0), b3, voffB); PG8_STAGE(PG8_SB(1, 1), b3 + hstep, voffB); PG8_STAGE(PG8_SA(1, 0), a3, voffA);
            PG8_WAIT_V(8); PG8_WAIT_L(0); PG8_BAR; PG8_MMA(1, 0, At, B0); PG8_MMA(1, 1, At, B1); PG8_BAR; PG8_SCHED;
            } else {
            PG8_LDB(B0, 0, 0); PG8_SCHED; PG8_LDA(At, 0, 0); PG8_STAGE(PG8_SA(1, 1), a1 + hstep, voffA);
            PG8_WAIT_L(8); PG8_BAR; PG8_WAIT_L(0); PG8_MMA(0, 0, At, B0); PG8_BAR; PG8_SCHED;
            PG8_LDB(B1, 0, 1); PG8_STAGE(PG8_SB(0, 0), b2, voffB);
            PG8_BAR; PG8_WAIT_L(0); PG8_MMA(0, 1, At, B1); PG8_BAR;
            PG8_LDA(At, 0, 1); PG8_STAGE(PG8_SA(0, 0), a2, voffA);
            PG8_BAR; PG8_WAIT_L(0); PG8_MMA(1, 0, At, B0); PG8_BAR; PG8_SCHED;
            PG8_STAGE(PG8_SB(0, 1), b2 + hstep, voffB);
            PG8_WAIT_V(6); PG8_BAR; PG8_MMA(1, 1, At, B1); PG8_BAR;
            PG8_LDB(B0, 1, 0); PG8_SCHED; PG8_LDA(At, 1, 0); PG8_STAGE(PG8_SA(0, 1), a2 + hstep, voffA);
            PG8_WAIT_L(8); PG8_BAR; PG8_WAIT_L(0); PG8_MMA(0, 0, At, B0); PG8_BAR; PG8_SCHED;
            PG8_LDB(B1, 1, 1); PG8_STAGE(PG8_SB(1, 0), b3, voffB);
            PG8_BAR; PG8_WAIT_L(0); PG8_MMA(0, 1, At, B1); PG8_BAR;
            PG8_LDA(At, 1, 1); PG8_STAGE(PG8_SA(1, 0), a3, voffA);
            PG8_BAR; PG8_WAIT_L(0); PG8_MMA(1, 0, At, B0); PG8_BAR; PG8_SCHED;
            PG8_STAGE(PG8_SB(1, 1), b3 + hstep, voffB);
            PG8_WAIT_V(6); PG8_BAR; PG8_MMA(1, 1, At, B1); PG8_BAR;
            }
        }
        if constexpr (Epi::LDS_SCALE) { if (has_next) __builtin_amdgcn_global_load_lds((const unsigned*)(E.scale_base(nxt, wid) + lane), (PG8_LAS unsigned*)(lds + SCL_OFF + ((ui + 1) & 1) * 2048 + wid * 256), 4, 0, 0); }
        if constexpr (ALIGN_EPI) { if (wr == 0) PG8_BAR; }
        if constexpr (!Epi::AFTER_DRAIN) { if constexpr (Epi::LDS_SCALE) E(acc, cur, wr, wc, fr, fq, (const PG8_LAS float*)(lds + SCL_OFF + (ui & 1) * 2048)); else E(acc, cur, wr, wc, fr, fq); S.done(cur); }
        if (!has_next) break;
#pragma unroll
        for (int a = 0; a < 2; ++a)
#pragma unroll
            for (int b = 0; b < 2; ++b)
#pragma unroll
                for (int m = 0; m < 4; ++m)
#pragma unroll
                    for (int n = 0; n < 2; ++n) acc[a][b][m][n] = (f32x4){0.f, 0.f, 0.f, 0.f};
        cur = nxt; cA = nA; cB = nB; ++ui;
        if constexpr (ALIGN_EPI) { if (wr == 1) PG8_BAR; }
    }
    PG8_WAIT_V(0);
    if constexpr (!ALIGN_EPI) { if (wr == 0) PG8_BAR; }
    PG8_BAR;
    if constexpr (Epi::AFTER_DRAIN) { E.fused(acc, cur, wr, wc, fr, fq, lds, wid, lane); S.done(cur); }
#undef PG8_SA
#undef PG8_SB
#undef PG8_STAGE
#undef PG8_LDA
#undef PG8_LDB
#undef PG8_MMA
#undef PG8_WAIT_V
#undef PG8_WAIT_L
#undef PG8_BAR
#undef PG8_SCHED
}
}
constexpr int RING_OFF = 0, RING_BYTES = 131072;
constexpr int LDSCTL_OFF = RING_BYTES, MISC_OFF = LDSCTL_OFF + 320;
constexpr int LDS_BYTES = 163840;
constexpr int HDS_OFF = 139264;
constexpr int TOPK_TAB_OFF = 139264;

struct Frame {
    LAS unsigned char* lds;
    volatile LAS unsigned* MISC;
    gu32* ctl;
    int tid, lane, wave, vcu, G;
    const float* const* in;
    float* out; unsigned char* ws;
};
enum { I_X = 0, I_C, I_WADA, I_BADA, I_GPRE1, I_GPOST1, I_GPRE2, I_GPOST2, I_WIN, I_LAMQK, I_GSUB, I_LBTH, I_GHOUT, I_WOUT, I_WPQ, I_KEYS, I_EU, I_EV };

__device__ __forceinline__ void p0_transpose_item(const float* W, int K, int N, int src_col0, bf16* WT, int dst_row0, LAS float* scr, int kb, int lane) {
    const int k0 = 64 * kb;
#pragma unroll 8
    for (int i = 0; i < 32; ++i) { const int kk = 2 * i + (lane >> 5); scr[kk * 33 + (lane & 31)] = W[(size_t)(k0 + kk) * N + src_col0 + (lane & 31)]; }
    LDS_WAIT(); asm volatile("" ::: "memory");
    const int c = lane & 7;
#pragma unroll
    for (int j = 0; j < 4; ++j) { const int n = (lane >> 3) + 8 * j; const LAS float* s = scr + (8 * c) * 33 + n;
        v4u o; o.x = pk2(s[0 * 33], s[1 * 33]); o.y = pk2(s[2 * 33], s[3 * 33]); o.z = pk2(s[4 * 33], s[5 * 33]); o.w = pk2(s[6 * 33], s[7 * 33]);
        *(GAS v4u*)(WT + (size_t)(dst_row0 + n) * K + k0 + 8 * c) = o; }
    LDS_WAIT(); asm volatile("" ::: "memory");
}
__device__ __forceinline__ int win_src_col(int n) {
    if (n < C_HQ || n >= C_HI) return n;
    const int h = (n - C_HQ) >> 8, c = (n - C_HQ) & 255;
    return c < 128 ? C_HQ + 128 * h + c : C_HF + 128 * h + (c - 128);
}
__device__ __forceinline__ void cvt_plain(const float* src, bf16* dst, size_t ngroups, size_t g0, size_t gstride) {
    for (size_t gi = g0; gi < ngroups; gi += gstride) {
        const f32x4 a = *(const GAS f32x4*)(src + gi * 8), b = *(const GAS f32x4*)(src + gi * 8 + 4);
        v4u o; o.x = pk2(a.x, a.y); o.y = pk2(a.z, a.w); o.z = pk2(b.x, b.y); o.w = pk2(b.z, b.w);
        *(GAS v4u*)(dst + gi * 8) = o;
    }
}
__device__ __forceinline__ void p0a(Frame& F) {
    LAS float* scr = (LAS float*)(F.lds + RING_OFF + F.wave * 16384);
    const int gw = F.vcu * NWAVES + F.wave, NGW = F.G * NWAVES;
    bf16* WIN = (bf16*)(F.ws + WS_WIN); bf16* WOUT = (bf16*)(F.ws + WS_WOUT); bf16* WPQ = (bf16*)(F.ws + WS_WPQ);
    constexpr int I1 = 16 * (INC / 32), I2 = 16 * (D / 32), I3 = 16 * (NPQ / 32);
    for (int it = gw; it < I1 + I2 + I3; it += NGW) {
        int r = it;
        if (r < I1) {
            const int kb = r / (INC / 32), nb = r % (INC / 32); const float* W = F.in[I_WIN]; const int sc = win_src_col(nb * 32) + (F.lane & 31); float am = 0.f;
#pragma unroll 8
            for (int i = 0; i < 32; ++i) am = fmaxf(am, fabsf(W[(size_t)(64 * kb + 2 * i + (F.lane >> 5)) * INC + sc]));
            am = fmaxf(am, __shfl_xor(am, 32));
            if (F.lane < 32) atomicMax((int*)(F.ws + WS_CS) + nb * 32 + F.lane, __builtin_bit_cast(int, am));
            continue; } r -= I1;
        if (r < I2) { const int kb = r / (D / 32), nb = r % (D / 32); p0_transpose_item(F.in[I_WOUT], D, D, nb * 32, WOUT, nb * 32, scr, kb, F.lane); continue; } r -= I2;
        { const int kb = r / (NPQ / 32), nb = r % (NPQ / 32); const float* W = F.in[I_WPQ]; const int sc = nb * 32 + (F.lane & 31); float am = 0.f;
#pragma unroll 8
          for (int i = 0; i < 32; ++i) am = fmaxf(am, fabsf(W[(size_t)(64 * kb + 2 * i + (F.lane >> 5)) * NPQ + sc]));
          am = fmaxf(am, __shfl_xor(am, 32));
          if (F.lane < 32) atomicMax((int*)(F.ws + WS_CS2) + nb * 32 + F.lane, __builtin_bit_cast(int, am)); }
    }
    const size_t g0 = (size_t)gw * 64 + F.lane, gs = (size_t)NGW * 64;
    cvt_plain(F.in[I_KEYS], (bf16*)(F.ws + WS_KEYS), (size_t)16 * 128 * 128 / 8, g0, gs);
    for (int r0 = gw; r0 < 2 * NEXP; r0 += 4 * NGW) {
        f32x4 v[4][4];
#pragma unroll
        for (int q = 0; q < 4; ++q) { const int r = r0 + q * NGW; const bool isv = r >= NEXP; const int e = isv ? r - NEXP : r;
            const GAS f32x4* src = (const GAS f32x4*)((isv ? F.in[I_EV] : F.in[I_EU]) + (size_t)e * D) + F.lane;
#pragma unroll
            for (int j = 0; j < 4; ++j) v[q][j] = __builtin_nontemporal_load(src + 64 * j); }
#pragma unroll
        for (int q = 0; q < 4; ++q) { const int r = r0 + q * NGW; const bool isv = r >= NEXP; const int e = isv ? r - NEXP : r; float am = 0.f;
#pragma unroll
            for (int j = 0; j < 4; ++j) am = fmaxf(am, fmaxf(fmaxf(fabsf(v[q][j].x), fabsf(v[q][j].y)), fmaxf(fabsf(v[q][j].z), fabsf(v[q][j].w))));
            am = fmaxf(wave_max_fast(am), 1e-30f);
            const float inv = 127.f / am;
            GAS unsigned* dst = (GAS unsigned*)(F.ws + (isv ? WS_EV8 : WS_EU8) + (size_t)e * D) + F.lane;
#pragma unroll
            for (int j = 0; j < 4; ++j) {
                const int q0 = (int)rintf(v[q][j].x * inv), q1 = (int)rintf(v[q][j].y * inv), q2 = (int)rintf(v[q][j].z * inv), q3 = (int)rintf(v[q][j].w * inv);
                dst[64 * j] = (unsigned)(q0 & 255) | ((unsigned)(q1 & 255) << 8) | ((unsigned)(q2 & 255) << 16) | ((unsigned)(q3 & 255) << 24);
            }
            if (F.lane == 0) ((float*)(F.ws + WS_SU))[2 * e + (isv ? 1 : 0)] = am * (1.f / 127.f); }
    }
    __syncthreads();
    if (F.vcu < NMOD / 32) { LAS float* cs = (LAS float*)(F.lds + RING_OFF + 32768); const float* cc = F.in[I_C];
        for (int i = F.tid; i < NB * D; i += NWAVES * 64) cs[i] = siluf(cc[i]);
        __syncthreads(); }
    for (int item = F.vcu; item < NMOD / 32; item += F.G) {
        const int n0 = item * 32, col = F.lane & 31, kh = F.lane >> 5;
        const float* wa = F.in[I_WADA]; LAS const float* cs = (LAS const float*)(F.lds + RING_OFF + 32768);
        float acc[NB];
#pragma unroll
        for (int b = 0; b < NB; ++b) acc[b] = 0.f;
#pragma unroll 8
        for (int i = 0; i < 64; ++i) {
            const int k = 128 * F.wave + 2 * i + kh;
            const float wv = __builtin_nontemporal_load(wa + (size_t)k * NMOD + n0 + col);
#pragma unroll
            for (int b = 0; b < NB; ++b) acc[b] += cs[b * D + k] * wv;
        }
        LAS float* red = (LAS float*)(F.lds + RING_OFF);
#pragma unroll
        for (int b = 0; b < NB; ++b) red[((F.wave * 2 + kh) * 8 + b) * 32 + col] = acc[b];
        __syncthreads();
        if (F.tid < 256) { float s = 0.f;
#pragma unroll
            for (int p = 0; p < 16; ++p) s += red[p * 256 + F.tid];
            ((float*)(F.ws + WS_MOD))[(F.tid >> 5) * NMOD + n0 + (F.tid & 31)] = s + F.in[I_BADA][n0 + (F.tid & 31)]; }
        __syncthreads();
    }
    if (F.vcu == F.G - 1 && F.wave == 0) {
        float* misc = (float*)(F.ws + WS_MISC); const float* lq = F.in[I_LAMQK]; const float* lt = F.in[I_LBTH]; const int l = F.lane;
        const float a = wave_sum(lq[l] * lq[64 + l]), b = wave_sum(lq[128 + l] * lq[192 + l]);
        if (l == 0) misc[0] = __expf(a) - __expf(b) + LAM_INIT;
        for (int i = l; i < 512; i += 64) misc[64 + i] = 1.f / (1.f + __expf(lt[512 + i] - lt[i]));
    }
}
__device__ __forceinline__ void p0_qtranspose_item(const float* W, int K, int N, int src_col0, signed char* WT, int dst_row0, const float* amax, LAS float* scr, int kb, int lane) {
    const int k0 = 64 * kb;
#pragma unroll 8
    for (int i = 0; i < 32; ++i) { const int kk = 2 * i + (lane >> 5); scr[kk * 33 + (lane & 31)] = W[(size_t)(k0 + kk) * N + src_col0 + (lane & 31)]; }
    LDS_WAIT(); asm volatile("" ::: "memory");
    const int c = lane & 7;
#pragma unroll
    for (int j = 0; j < 4; ++j) { const int n = (lane >> 3) + 8 * j; const LAS float* s = scr + (8 * c) * 33 + n;
        const float inv = 127.f / fmaxf(amax[dst_row0 + n], 1e-30f);
        int q[8];
#pragma unroll
        for (int e = 0; e < 8; ++e) q[e] = (int)rintf(s[e * 33] * inv) & 255;
        v2u o; o.x = (unsigned)q[0] | ((unsigned)q[1] << 8) | ((unsigned)q[2] << 16) | ((unsigned)q[3] << 24); o.y = (unsigned)q[4] | ((unsigned)q[5] << 8) | ((unsigned)q[6] << 16) | ((unsigned)q[7] << 24);
        *(GAS v2u*)(WT + (size_t)(dst_row0 + n) * K + k0 + 8 * c) = o; }
    LDS_WAIT(); asm volatile("" ::: "memory");
}
__device__ __forceinline__ void p0b(Frame& F) {
    const int gw = F.vcu * NWAVES + F.wave, NGW = F.G * NWAVES;
    { LAS float* scr = (LAS float*)(F.lds + RING_OFF + F.wave * 16384);
      for (int it = gw; it < 16 * (INC / 32); it += NGW) { const int kb = it / (INC / 32), nb = it % (INC / 32);
          p0_qtranspose_item(F.in[I_WIN], D, INC, win_src_col(nb * 32), (signed char*)(F.ws + WS_WIN), nb * 32, (const float*)(F.ws + WS_CS), scr, kb, F.lane); }
      for (int it = gw; it < 16 * (NPQ / 32); it += NGW) { const int kb = it / (NPQ / 32), nb = it % (NPQ / 32);
          p0_qtranspose_item(F.in[I_WPQ], D, NPQ, nb * 32, (signed char*)(F.ws + WS_WPQ), nb * 32, (const float*)(F.ws + WS_CS2), scr, kb, F.lane); } }
    const float* x = F.in[I_X]; const float* g = F.in[I_GPRE1]; const float* mod = (const float*)(F.ws + WS_MOD);
    f32x4 pg[4], psc[4], psh[4];
    { const int b = (16 * gw) / S;
#pragma unroll
      for (int j = 0; j < 4; ++j) { const int col = (F.lane + 64 * j) * 4; pg[j] = *(const f32x4*)(g + col); psc[j] = 1.f + *(const f32x4*)(mod + b * NMOD + D + col); psh[j] = *(const f32x4*)(mod + b * NMOD + col); } }
#pragma unroll 1
    for (int m0 = 16 * gw; m0 < 16 * gw + 16; m0 += 4) {
        f32x4 v[4][4];
#pragma unroll
        for (int q = 0; q < 4; ++q) { const GAS f32x4* xr = (const GAS f32x4*)(x + (size_t)(m0 + q) * D) + F.lane;
#pragma unroll
            for (int j = 0; j < 4; ++j) v[q][j] = __builtin_nontemporal_load(xr + 64 * j); }
#pragma unroll
        for (int q = 0; q < 4; ++q) {
            const int m = m0 + q; float ss = 0.f;
#pragma unroll
            for (int j = 0; j < 4; ++j) ss += (v[q][j].x * v[q][j].x + v[q][j].y * v[q][j].y) + (v[q][j].z * v[q][j].z + v[q][j].w * v[q][j].w);
            const float r = rsqrtf(wave_sum_fast(ss) * (1.f / D) + EPS);
            float am = 0.f;
#pragma unroll
            for (int j = 0; j < 4; ++j) {
                const f32x4 y = v[q][j] * r * pg[j] * psc[j] + psh[j]; v[q][j] = y;
                am = fmaxf(am, fmaxf(fmaxf(fabsf(y.x), fabsf(y.y)), fmaxf(fabsf(y.z), fabsf(y.w)))); }
            am = fmaxf(wave_max_fast(am), 1e-30f);
            const float inv = 127.f / am;
            GAS unsigned* h8 = (GAS unsigned*)(F.ws + WS_H + (size_t)m * D) + F.lane;
#pragma unroll
            for (int j = 0; j < 4; ++j) { const int q0 = (int)rintf(v[q][j].x * inv), q1 = (int)rintf(v[q][j].y * inv), q2 = (int)rintf(v[q][j].z * inv), q3 = (int)rintf(v[q][j].w * inv);
                h8[64 * j] = (unsigned)(q0 & 255) | ((unsigned)(q1 & 255) << 8) | ((unsigned)(q2 & 255) << 16) | ((unsigned)(q3 & 255) << 24); }
            if (F.lane == 0) ((float*)(F.ws + WS_RS))[m] = am * (1.f / 127.f);
        }
    }
}
struct EpiProj {
    static constexpr bool PERM = true, AFTER_DRAIN = false, LDS_SCALE = true;
    __device__ __forceinline__ const float* scale_base(const pg8::Unit& u, int wid) const { return wid < 4 ? RS + u.pm * 256 + wid * 64 : CS + u.pn * 256 + (wid - 4) * 64; }
    bf16* P; float* HD; const LAS float* lb; const float* RS; const float* CS;
    __device__ __forceinline__ void operator()(const pg8::f32x4 (&acc)[2][2][4][2], const pg8::Unit& u, int wr, int wc, int fr, int fq, const LAS float* scl) const {
        const int pn = u.pn, row0 = u.pm * 256 + wr * 64 + fr, cl = wc * 32 + 8 * fq;
        float rsc[2][4], csc[2][8];
#pragma unroll
        for (int ai = 0; ai < 2; ++ai)
#pragma unroll
            for (int mm = 0; mm < 4; ++mm) rsc[ai][mm] = scl[wr * 64 + fr + ai * 128 + mm * 16] * (1.f / 127.f);
#pragma unroll
        for (int bj = 0; bj < 2; ++bj)
#pragma unroll
            for (int i = 0; i < 8; ++i) csc[bj][i] = scl[256 + bj * 128 + cl + i];
#define DEQ(ai_, bj_, m_, n_, j_) ((float)(__builtin_bit_cast(pg8::i32x4, acc[ai_][bj_][m_][n_])[j_]) * rsc[ai_][m_] * csc[bj_][4 * (n_) + (j_)])
        if (pn >= 6 && pn < 10) {
            const int h = pn - 6;
            bf16* HQ = P + 3 * PSTRIDE; bf16* HK = P + 4 * PSTRIDE;
            float lbv[8];
#pragma unroll
            for (int i = 0; i < 8; ++i) lbv[i] = lb[h * 128 + cl + i];
#pragma unroll
            for (int ai = 0; ai < 2; ++ai) {
                float qt[4][8], kt[4][8], dl[8];
#pragma unroll
                for (int n = 0; n < 2; ++n)
#pragma unroll
                    for (int j = 0; j < 4; ++j) {
                        const int i = 4 * n + j; float carry = 1.f;
#pragma unroll
                        for (int m = 0; m < 4; ++m) {
                            const float aq = DEQ(ai, 0, m, n, j), af = DEQ(ai, 1, m, n, j);
                            const float f = lbv[i] + (1.f - lbv[i]) * sigmf(af);
                            float p = f;
                            p *= dpp_one<0x111>(p); p *= dpp_one<0x112>(p); p *= dpp_one<0x114>(p); p *= dpp_one<0x118>(p);
                            p *= carry; carry = __shfl(p, 15, 16);
                            qt[m][i] = siluf(aq) * p; kt[m][i] = (1.f - f) * __builtin_amdgcn_rcpf(p);
                            if (m == 3) dl[i] = p;
                        }
                    }
#pragma unroll
                for (int m = 0; m < 4; ++m) {
                    const size_t off = (size_t)(row0 + ai * 128 + m * 16) * 512 + h * 128 + cl;
                    v4u w; w.x = pk2(qt[m][0], qt[m][1]); w.y = pk2(qt[m][2], qt[m][3]); w.z = pk2(qt[m][4], qt[m][5]); w.w = pk2(qt[m][6], qt[m][7]);
                    *(GAS v4u*)(HQ + off) = w;
                    w.x = pk2(kt[m][0], kt[m][1]); w.y = pk2(kt[m][2], kt[m][3]); w.z = pk2(kt[m][4], kt[m][5]); w.w = pk2(kt[m][6], kt[m][7]);
                    *(GAS v4u*)(HK + off) = w;
                }
                if (fr == 15) { float* dp = HD + (size_t)(u.pm * 4 + ai * 2 + wr) * 512 + h * 128 + cl;
                    *(GAS f32x4*)dp = (f32x4){dl[0], dl[1], dl[2], dl[3]}; *(GAS f32x4*)(dp + 4) = (f32x4){dl[4], dl[5], dl[6], dl[7]}; }
            }
        } else {
            bf16* O = P + (size_t)(pn >> 1) * PSTRIDE;
            const int colt = (pn & 1) * 256 + cl;
            const float sc = pn < 2 ? QSCALE : 1.f;
            f32x2 c2[2][4];
#pragma unroll
            for (int bj = 0; bj < 2; ++bj)
#pragma unroll
                for (int q = 0; q < 4; ++q) c2[bj][q] = (f32x2){csc[bj][2 * q] * sc, csc[bj][2 * q + 1] * sc};
#pragma unroll
            for (int ai = 0; ai < 2; ++ai)
#pragma unroll
                for (int m = 0; m < 4; ++m) {
                    bf16* rowp = O + (size_t)(row0 + ai * 128 + m * 16) * 512 + colt;
                    const f32x2 rs2 = (f32x2){rsc[ai][m], rsc[ai][m]};
#pragma unroll
                    for (int bj = 0; bj < 2; ++bj) {
                        const pg8::i32x4 i0 = __builtin_bit_cast(pg8::i32x4, acc[ai][bj][m][0]), i1 = __builtin_bit_cast(pg8::i32x4, acc[ai][bj][m][1]);
                        f32x2 e0 = (f32x2){(float)i0[0], (float)i0[1]} * rs2 * c2[bj][0], e1 = (f32x2){(float)i0[2], (float)i0[3]} * rs2 * c2[bj][1];
                        f32x2 e2 = (f32x2){(float)i1[0], (float)i1[1]} * rs2 * c2[bj][2], e3 = (f32x2){(float)i1[2], (float)i1[3]} * rs2 * c2[bj][3];
                        if (pn >= 12) { e0 = (f32x2){siluf(e0.x), siluf(e0.y)}; e1 = (f32x2){siluf(e1.x), siluf(e1.y)}; e2 = (f32x2){siluf(e2.x), siluf(e2.y)}; e3 = (f32x2){siluf(e3.x), siluf(e3.y)}; }
                        v4u w; w.x = pk2(e0.x, e0.y); w.y = pk2(e1.x, e1.y); w.z = pk2(e2.x, e2.y); w.w = pk2(e3.x, e3.y);
                        *(GAS v4u*)(rowp + bj * 128) = w;
                    }
                }
        }
    }
};
namespace attn {
constexpr int NSLOT = 4, SLOT = 16384, KOFF = 0, VOFF = NSLOT * SLOT, SCR = LDSCTL_OFF + 4096;
constexpr float THR = 8.f;
__device__ __forceinline__ int crow(int r, int hi) { return (r & 3) + 8 * (r >> 2) + 4 * hi; }
__device__ __forceinline__ unsigned cvtpk(float lo, float hi) { typedef float f2 __attribute__((ext_vector_type(2))); typedef __bf16 b2 __attribute__((ext_vector_type(2)));
    f2 v = {lo, hi}; b2 b = __builtin_convertvector(v, b2); return __builtin_bit_cast(unsigned, b); }
typedef short v4i16_t __attribute__((ext_vector_type(4)));
__device__ __forceinline__ s16x4 vtr(LAS const unsigned char* p) { return __builtin_bit_cast(s16x4, __builtin_amdgcn_ds_read_tr16_b64_v4i16((LAS v4i16_t*)p)); }
__device__ __forceinline__ float max3f(float a, float b, float c) { float r; asm("v_max3_f32 %0, %1, %2, %3" : "=v"(r) : "v"(a), "v"(b), "v"(c)); return r; }
#define ATT_WAITBAR(N) asm volatile("s_waitcnt vmcnt(" #N ") lgkmcnt(0)\n\ts_barrier" ::: "memory")

__device__ __forceinline__ void attn_unit(int b, int h, int qb, const bf16* QA, const bf16* KA, const bf16* VA, bf16* CAT, const float lam, const float* g_sub, LAS unsigned char* lds) {
    const int tid = threadIdx.x, lane = tid & 63, r32 = lane & 31, hi = lane >> 5;
    const int wave = __builtin_amdgcn_readfirstlane(tid >> 6), rg = wave >> 1, j = wave & 1;
    const size_t rowbase = (size_t)b * S; const int q0 = qb * 128, R0 = q0 + 32 * rg;
    const int NT = (q0 + 128) / 64;
    unsigned goff[2];
#pragma unroll
    for (int i = 0; i < 2; ++i) { const int p = wave * 2 + i, row = 4 * p + (lane >> 4), chp = lane & 15, sw = ((row & 3) << 2) | ((row >> 2) & 3);
        goff[i] = (unsigned)(row * 1024 + ((chp ^ sw) << 4)); }
    const unsigned char* kbase = (const unsigned char*)(KA + rowbase * 512 + h * 128);
    const unsigned char* vbase = (const unsigned char*)(VA + rowbase * 512 + h * 128);
#define ATT_ISSUE(t, slot) do { const size_t to_ = (size_t)(t) * 64 * 1024; _Pragma("unroll") for (int i_ = 0; i_ < 2; ++i_) { \
        glds16(kbase + to_ + goff[i_], lds_addr(lds + KOFF + (slot) * SLOT + (wave * 2 + i_) * 1024)); \
        glds16(vbase + to_ + goff[i_], lds_addr(lds + VOFF + (slot) * SLOT + (wave * 2 + i_) * 1024)); } } while (0)
    int koffs[4];
    { const int sw = ((r32 & 3) << 2) | ((r32 >> 2) & 3);
#pragma unroll
      for (int ks = 0; ks < 4; ++ks) koffs[ks] = r32 * 256 + (((8 * j + 2 * ks + hi) ^ sw) << 4); }
    int voffs[2][4];
    { const int g = lane >> 4, i = lane & 15, qq = i >> 2, p = i & 3;
#pragma unroll
      for (int a = 0; a < 2; ++a)
#pragma unroll
          for (int db = 0; db < 4; ++db) voffs[a][db] = (8 * a + 4 * hi + qq) * 256 + ((((db ^ qq) << 2) | ((2 * (g & 1) + (p >> 1)) ^ ((2 * a + hi) & 3))) << 4) + 8 * (p & 1); }
    bf16x8 qr[4];
    { const bf16* qp = QA + (rowbase + R0 + r32) * 512 + h * 128 + j * 64 + hi * 8;
#pragma unroll
      for (int ks = 0; ks < 4; ++ks) qr[ks] = *(const GAS bf16x8*)(qp + ks * 16); }
    ATT_ISSUE(0, 0); ATT_ISSUE(1, 1);
    f32x16 o[4];
#pragma unroll
    for (int db = 0; db < 4; ++db) o[db] = (f32x16){0.f, 0.f, 0.f, 0.f, 0.f, 0.f, 0.f, 0.f, 0.f, 0.f, 0.f, 0.f, 0.f, 0.f, 0.f, 0.f};
    float m = -INFINITY, l = 0.f;
    LAS float* wsf = (LAS float*)(lds + SCR + wave * 256);
    const int last = (R0 + 31) >> 6;
#define ATT_LOADV(buf_, s_) do { _Pragma("unroll") for (int db = 0; db < 4; ++db) { \
        const s16x4 lo_ = vtr(Vs + (s_) * 4096 + voffs[0][db]), hh_ = vtr(Vs + (s_) * 4096 + voffs[1][db]); \
        vbuf[buf_][db] = (bf16x8){lo_[0], lo_[1], lo_[2], lo_[3], hh_[0], hh_[1], hh_[2], hh_[3]}; } } while (0)
    const int grp = wave >> 2;
    bf16x8 pa[4];
#pragma unroll
    for (int s = 0; s < 4; ++s) pa[s] = (bf16x8){0, 0, 0, 0, 0, 0, 0, 0};
#define ATT_PV(Vs_) do { LAS const unsigned char* Vs = (Vs_); bf16x8 vbuf[2][4]; ATT_LOADV(0, 0); \
        _Pragma("unroll") for (int s = 0; s < 4; ++s) { if (s < 3) ATT_LOADV((s + 1) & 1, s + 1); __builtin_amdgcn_sched_barrier(0); \
            _Pragma("unroll") for (int db = 0; db < 4; ++db) o[db] = __builtin_amdgcn_mfma_f32_32x32x16_bf16(pa[s], vbuf[s & 1][db], o[db], 0, 0, 0); \
            __builtin_amdgcn_sched_barrier(0); } } while (0)
    int slot = 0;
    for (int t = 0; t < NT; ++t) {
        if (t + 1 < NT) { ATT_WAITBAR(4); } else { ATT_WAITBAR(0); }
        if (t + 2 < NT) ATT_ISSUE(t + 2, (slot + 2) & 3);
        const int k0 = 64 * t;
        if (grp == 1 && t >= 1 && t - 1 <= last) ATT_PV(lds + VOFF + ((slot + 3) & 3) * SLOT);
        if (t <= last) {
            LAS const unsigned char* Ks = lds + KOFF + slot * SLOT;
            bf16x8 kf[8];
#pragma unroll
            for (int ks = 0; ks < 4; ++ks) { kf[2 * ks] = *(LAS const bf16x8*)(Ks + koffs[ks]); kf[2 * ks + 1] = *(LAS const bf16x8*)(Ks + 8192 + koffs[ks]); }
            __builtin_amdgcn_sched_barrier(0);
            f32x16 p0 = (f32x16){0.f, 0.f, 0.f, 0.f, 0.f, 0.f, 0.f, 0.f, 0.f, 0.f, 0.f, 0.f, 0.f, 0.f, 0.f, 0.f}, p1 = p0;
#pragma unroll
            for (int ks = 0; ks < 4; ++ks) {
                p0 = __builtin_amdgcn_mfma_f32_32x32x16_bf16(kf[2 * ks], qr[ks], p0, 0, 0, 0);
                p1 = __builtin_amdgcn_mfma_f32_32x32x16_bf16(kf[2 * ks + 1], qr[ks], p1, 0, 0, 0);
            }
            if (k0 + 63 > R0) {
                const int qrow = R0 + r32;
#pragma unroll
                for (int r = 0; r < 16; ++r) { const int kv = k0 + crow(r, hi); if (kv > qrow) p0[r] = -INFINITY; if (kv + 32 > qrow) p1[r] = -INFINITY; }
            }
            float rm = fmaxf(p0[0], p1[0]), rm2 = fmaxf(p0[1], p1[1]);
#pragma unroll
            for (int r = 2; r < 16; r += 2) { rm = max3f(rm, p0[r], p1[r]); rm2 = max3f(rm2, p0[r + 1], p1[r + 1]); }
            rm = fmaxf(rm, rm2);
            rm = fmaxf(rm, __shfl_xor(rm, 32));
            if (__any(rm > m + THR)) {
                const float mn = fmaxf(m, rm), al = __builtin_amdgcn_exp2f(m - mn);
                m = mn; l *= al;
                if (hi == 0) wsf[r32] = al;
                LDS_WAIT();
#pragma unroll
                for (int g4 = 0; g4 < 4; ++g4) { const f32x4 a4 = *(LAS const f32x4*)(wsf + 8 * g4 + 4 * hi);
#pragma unroll
                    for (int db = 0; db < 4; ++db) { o[db][4 * g4] *= a4.x; o[db][4 * g4 + 1] *= a4.y; o[db][4 * g4 + 2] *= a4.z; o[db][4 * g4 + 3] *= a4.w; } }
            }
            typedef float f2 __attribute__((ext_vector_type(2)));
            f2 sacc2 = (f2){0.f, 0.f};
#pragma unroll
            for (int r = 0; r < 16; ++r) { p0[r] = __builtin_amdgcn_exp2f(p0[r] - m); p1[r] = __builtin_amdgcn_exp2f(p1[r] - m); sacc2 += (f2){p0[r], p1[r]}; }
            l += sacc2.x + sacc2.y;
#pragma unroll
            for (int s = 0; s < 2; ++s) {
                v4u w0, w1;
                w0.x = cvtpk(p0[8 * s], p0[8 * s + 1]); w0.y = cvtpk(p0[8 * s + 2], p0[8 * s + 3]); w0.z = cvtpk(p0[8 * s + 4], p0[8 * s + 5]); w0.w = cvtpk(p0[8 * s + 6], p0[8 * s + 7]);
                w1.x = cvtpk(p1[8 * s], p1[8 * s + 1]); w1.y = cvtpk(p1[8 * s + 2], p1[8 * s + 3]); w1.z = cvtpk(p1[8 * s + 4], p1[8 * s + 5]); w1.w = cvtpk(p1[8 * s + 6], p1[8 * s + 7]);
                pa[s] = __builtin_bit_cast(bf16x8, w0); pa[2 + s] = __builtin_bit_cast(bf16x8, w1);
            }
            __builtin_amdgcn_sched_barrier(0);
            if (grp == 0) ATT_PV(lds + VOFF + slot * SLOT);
        }
        slot = (slot + 1) & 3;
    }
    if (grp == 1 && NT - 1 <= last) { ATT_PV(lds + VOFF + ((slot + 3) & 3) * SLOT); }
#undef ATT_PV
#undef ATT_LOADV
    ATT_WAITBAR(0);
    l += __shfl_xor(l, 32);
    if (hi == 0) wsf[r32] = 1.f / l;
    LDS_WAIT();
#pragma unroll
    for (int g4 = 0; g4 < 4; ++g4) { const f32x4 a4 = *(LAS const f32x4*)(wsf + 8 * g4 + 4 * hi);
#pragma unroll
        for (int db = 0; db < 4; ++db) { o[db][4 * g4] *= a4.x; o[db][4 * g4 + 1] *= a4.y; o[db][4 * g4 + 2] *= a4.z; o[db][4 * g4 + 3] *= a4.w; } }
    LAS float* xch = (LAS float*)(lds + rg * 16384) + lane;
    if (j == 1) {
#pragma unroll
        for (int db = 0; db < 4; ++db)
#pragma unroll
            for (int r = 0; r < 16; ++r) xch[(db * 16 + r) * 64] = o[db][r];
    }
    ATT_WAITBAR(0);
    if (j == 0) {
        float gs[4];
#pragma unroll
        for (int db = 0; db < 4; ++db) gs[db] = g_sub[32 * db + r32] * (1.f - LAM_INIT);
#pragma unroll
        for (int db = 0; db < 4; ++db)
#pragma unroll
            for (int r = 0; r < 16; ++r) o[db][r] -= lam * xch[(db * 16 + r) * 64];
        bf16* cp = CAT + (rowbase + R0) * D + h * 128 + r32;
#pragma unroll
        for (int r = 0; r < 16; ++r) {
            float ss = (o[0][r] * o[0][r] + o[1][r] * o[1][r]) + (o[2][r] * o[2][r] + o[3][r] * o[3][r]);
            ss += __shfl_xor(ss, 1); ss += __shfl_xor(ss, 2); ss += __shfl_xor(ss, 4); ss += __shfl_xor(ss, 8); ss += __shfl_xor(ss, 16);
            const float rn = rsqrtf(ss * (1.f / 128.f) + EPS);
            bf16* rp = cp + (size_t)crow(r, hi) * D;
#pragma unroll
            for (int db = 0; db < 4; ++db) rp[32 * db] = (bf16)f2bf(o[db][r] * rn * gs[db]);
        }
    }
    ATT_WAITBAR(0);
#undef ATT_ISSUE
}
__device__ __forceinline__ void attn_phase(Frame& F) {
    const bf16* P = (const bf16*)(F.ws + WS_P);
    const float lam = ((const float*)(F.ws + WS_MISC))[0];
    const int bh = F.vcu >> 3, s = F.vcu & 7;
    for (int i = 0; i < 4; ++i) {
        const int qb = (i == 0) ? s : (i == 1) ? 15 - s : (i == 2) ? 16 + s : 31 - s;
        attn_unit(bh >> 2, bh & 3, qb, P, P + PSTRIDE, P + 2 * PSTRIDE, (bf16*)(F.ws + WS_CAT), lam, F.in[I_GSUB], F.lds + RING_OFF);
    }
}
}
namespace hgrn {
using attn::crow; using attn::cvtpk; using attn::vtr;
constexpr int TILE = 16384;
#define HG_WAITBAR(N) asm volatile("s_waitcnt vmcnt(" #N ") lgkmcnt(0)\n\ts_barrier" ::: "memory")
struct Addr { unsigned goff[2]; int vb0, vb1, qq; };
__device__ __forceinline__ void make_addr(Addr& A, int wave, int lane, int npieces_per_wave_base) {
    const int hi = lane >> 5;
#pragma unroll
    for (int i = 0; i < 2; ++i) { const int p = npieces_per_wave_base + i, row = 4 * p + (lane >> 4), chp = lane & 15, sw = ((row & 3) << 2) | ((row >> 2) & 3);
        A.goff[i] = (unsigned)(row * 1024 + ((chp ^ sw) << 4)); }
    const int g = lane >> 4, i = lane & 15, qq = i >> 2, p = i & 3;
    A.qq = qq;
    A.vb0 = (4 * hi + qq) * 256 + (((2 * (g & 1) + (p >> 1)) ^ (hi & 3)) << 4) + 8 * (p & 1);
    A.vb1 = (8 + 4 * hi + qq) * 256 + (((2 * (g & 1) + (p >> 1)) ^ ((2 + hi) & 3)) << 4) + 8 * (p & 1);
}
__device__ __forceinline__ bf16x8 trfrag(LAS const unsigned char* tile, const Addr& A, int ss, int x) {
    const int xo = ((x ^ A.qq) & 3) << 6;
    const s16x4 lo = vtr(tile + ss * 4096 + A.vb0 + xo), hh = vtr(tile + ss * 4096 + A.vb1 + xo);
    return (bf16x8){lo[0], lo[1], lo[2], lo[3], hh[0], hh[1], hh[2], hh[3]};
}
__device__ __forceinline__ void pass_a(Frame& F) {
    LAS unsigned char* lds = F.lds + RING_OFF;
    const int lane = F.lane, wave = F.wave, r32 = lane & 31, hi = lane >> 5, sl = wave & 3, kh = wave >> 2;
    const int bh = F.vcu >> 3, sc = F.vcu & 7, b = bh >> 2, h = bh & 3;
    const size_t t0 = (size_t)b * S + sc * 512;
    const bf16* P = (const bf16*)(F.ws + WS_P);
    const unsigned char* kbase = (const unsigned char*)(P + 4 * PSTRIDE + t0 * 512 + h * 128);
    const unsigned char* vbase = (const unsigned char*)(P + 5 * PSTRIDE + t0 * 512 + h * 128);
    const float* HD = (const float*)(F.ws + WS_HD) + (size_t)(b * 64 + sc * 8) * 512 + h * 128;
    Addr A; make_addr(A, wave, lane, wave * 2);
    LAS float* hds = (LAS float*)(F.lds + HDS_OFF);
    *(LAS f32x2*)(hds + (F.tid >> 6) * 128 + 2 * (F.tid & 63)) = *(const GAS f32x2*)(HD + (size_t)(F.tid >> 6) * 512 + 2 * (F.tid & 63));
#define HGA_ISSUE(c, slot) do { const size_t to_ = (size_t)(c) * 64 * 1024; _Pragma("unroll") for (int i_ = 0; i_ < 2; ++i_) { \
        glds16(kbase + to_ + A.goff[i_], lds_addr(lds + (slot) * 2 * TILE + (wave * 2 + i_) * 1024)); \
        glds16(vbase + to_ + A.goff[i_], lds_addr(lds + (slot) * 2 * TILE + TILE + (wave * 2 + i_) * 1024)); } } while (0)
    HGA_ISSUE(0, 0); HGA_ISSUE(1, 1);
    f32x16 acc[2];
#pragma unroll
    for (int rb = 0; rb < 2; ++rb) acc[rb] = (f32x16){0.f, 0.f, 0.f, 0.f, 0.f, 0.f, 0.f, 0.f, 0.f, 0.f, 0.f, 0.f, 0.f, 0.f, 0.f, 0.f};
    int slot = 0;
    for (int c = 0; c < 8; ++c) {
        if (c + 1 < 8) { HG_WAITBAR(4); } else { HG_WAITBAR(0); }
        if (c + 2 < 8) { const int s2 = slot == 0 ? 2 : slot - 1; HGA_ISSUE(c + 2, s2); }
        LAS const unsigned char* KT = lds + slot * 2 * TILE; LAS const unsigned char* VT = KT + TILE;
#pragma unroll
        for (int ss = 0; ss < 4; ++ss) {
            const bf16x8 bfr = trfrag(VT, A, ss, sl);
#pragma unroll
            for (int rb = 0; rb < 2; ++rb) { const bf16x8 afr = trfrag(KT, A, ss, 2 * kh + rb); acc[rb] = __builtin_amdgcn_mfma_f32_32x32x16_bf16(afr, bfr, acc[rb], 0, 0, 0); }
        }
#pragma unroll
        for (int rb = 0; rb < 2; ++rb)
#pragma unroll
            for (int g4 = 0; g4 < 4; ++g4) { const f32x4 d4 = *(LAS const f32x4*)(hds + c * 128 + 32 * (2 * kh + rb) + 8 * g4 + 4 * hi);
                acc[rb][4 * g4] *= d4.x; acc[rb][4 * g4 + 1] *= d4.y; acc[rb][4 * g4 + 2] *= d4.z; acc[rb][4 * g4 + 3] *= d4.w; }
        slot = slot == 2 ? 0 : slot + 1;
    }
    float* L = (float*)(F.ws + WS_LSC) + (size_t)F.vcu * 16384;
#pragma unroll
    for (int rb = 0; rb < 2; ++rb)
#pragma unroll
        for (int r = 0; r < 16; ++r) L[(size_t)(32 * (2 * kh + rb) + crow(r, hi)) * 128 + 32 * sl + r32] = acc[rb][r];
    if (F.tid < 128) { float p = 1.f;
#pragma unroll
        for (int c = 0; c < 8; ++c) p *= hds[c * 128 + F.tid];
        ((float*)(F.ws + WS_DSC))[(size_t)F.vcu * 128 + F.tid] = p; }
    HG_WAITBAR(0);
#undef HGA_ISSUE
}
__device__ __forceinline__ void pass_c(Frame& F) {
    LAS unsigned char* lds = F.lds + RING_OFF;
    const int lane = F.lane, wave = F.wave, r32 = lane & 31, hi = lane >> 5, sl = wave & 3, th = wave >> 2;
    const int bh = F.vcu >> 3, sc = F.vcu & 7, b = bh >> 2, h = bh & 3;
    const size_t t0 = (size_t)b * S + sc * 512;
    const bf16* P = (const bf16*)(F.ws + WS_P);
    const unsigned char* qbase = (const unsigned char*)(P + 3 * PSTRIDE + t0 * 512 + h * 128);
    const unsigned char* kbase = (const unsigned char*)(P + 4 * PSTRIDE + t0 * 512 + h * 128);
    const unsigned char* vbase = (const unsigned char*)(P + 5 * PSTRIDE + t0 * 512 + h * 128);
    const bf16* HG = P + 6 * PSTRIDE;
    const float* HD = (const float*)(F.ws + WS_HD) + (size_t)(b * 64 + sc * 8) * 512 + h * 128;
    const float* g_out = F.in[I_GHOUT];
    bf16* CAT = (bf16*)(F.ws + WS_CAT);
    Addr A; make_addr(A, wave, lane, wave * 2);
    constexpr int SLOTB = 3 * TILE, OST = 2 * SLOTB;
#define HGC_ISSUE(c, slot) do { const size_t to_ = (size_t)(c) * 64 * 1024; _Pragma("unroll") for (int i_ = 0; i_ < 2; ++i_) { \
        glds16(qbase + to_ + A.goff[i_], lds_addr(lds + (slot) * SLOTB + (wave * 2 + i_) * 1024)); \
        glds16(kbase + to_ + A.goff[i_], lds_addr(lds + (slot) * SLOTB + TILE + (wave * 2 + i_) * 1024)); \
        glds16(vbase + to_ + A.goff[i_], lds_addr(lds + (slot) * SLOTB + 2 * TILE + (wave * 2 + i_) * 1024)); } } while (0)
    LAS float* hds = (LAS float*)(F.lds + HDS_OFF);
    *(LAS f32x2*)(hds + (F.tid >> 6) * 128 + 2 * (F.tid & 63)) = *(const GAS f32x2*)(HD + (size_t)(F.tid >> 6) * 512 + 2 * (F.tid & 63));
    HGC_ISSUE(0, 0);
    f32x16 st[4];
#pragma unroll
    for (int kb = 0; kb < 4; ++kb) st[kb] = (f32x16){0.f, 0.f, 0.f, 0.f, 0.f, 0.f, 0.f, 0.f, 0.f, 0.f, 0.f, 0.f, 0.f, 0.f, 0.f, 0.f};
    for (int i = 0; i < sc; ++i) {
        const float* L = (const float*)(F.ws + WS_LSC) + (size_t)(bh * 8 + i) * 16384;
        const float* Dt = (const float*)(F.ws + WS_DSC) + (size_t)(bh * 8 + i) * 128;
#pragma unroll
        for (int kb = 0; kb < 4; ++kb)
#pragma unroll
            for (int g4 = 0; g4 < 4; ++g4) { const f32x4 d4 = *(const GAS f32x4*)(Dt + 32 * kb + 8 * g4 + 4 * hi);
#pragma unroll
                for (int e = 0; e < 4; ++e) { const int r = 4 * g4 + e; st[kb][r] = st[kb][r] * d4[e] + L[(size_t)(32 * kb + crow(r, hi)) * 128 + 32 * sl + r32]; } }
    }
    float go[16];
#pragma unroll
    for (int e4 = 0; e4 < 4; ++e4) { const f32x4 gq = *(const f32x4*)(g_out + (lane & 7) * 16 + 4 * e4); go[4 * e4] = gq.x; go[4 * e4 + 1] = gq.y; go[4 * e4 + 2] = gq.z; go[4 * e4 + 3] = gq.w; }
    const int swq = ((r32 & 3) << 2) | ((r32 >> 2) & 3);
    for (int c = 0; c < 8; ++c) {
        const int slot = c & 1;
        HG_WAITBAR(0);
        const size_t grow = t0 + (size_t)c * 64 + 8 * wave + (lane >> 3);
        const v4u g0 = *(const GAS v4u*)(HG + grow * 512 + h * 128 + (lane & 7) * 16), g1 = *(const GAS v4u*)(HG + grow * 512 + h * 128 + (lane & 7) * 16 + 8);
        if (c + 1 < 8) HGC_ISSUE(c + 1, slot ^ 1);
        LAS const unsigned char* QT = lds + slot * SLOTB; LAS const unsigned char* KT = QT + TILE; LAS const unsigned char* VT = QT + 2 * TILE;
        f32x16 X0 = (f32x16){0.f, 0.f, 0.f, 0.f, 0.f, 0.f, 0.f, 0.f, 0.f, 0.f, 0.f, 0.f, 0.f, 0.f, 0.f, 0.f}, X1 = X0;
#pragma unroll
        for (int kk = 0; kk < 8; ++kk) {
            const int co = ((2 * kk + hi) ^ swq) << 4;
            const bf16x8 qf = *(LAS const bf16x8*)(QT + (32 * th + r32) * 256 + co);
            const bf16x8 k0 = *(LAS const bf16x8*)(KT + r32 * 256 + co);
            X0 = __builtin_amdgcn_mfma_f32_32x32x16_bf16(k0, qf, X0, 0, 0, 0);
            if (th == 1) { const bf16x8 k1 = *(LAS const bf16x8*)(KT + (32 + r32) * 256 + co); X1 = __builtin_amdgcn_mfma_f32_32x32x16_bf16(k1, qf, X1, 0, 0, 0); }
        }
        if (th == 0) {
#pragma unroll
            for (int r = 0; r < 16; ++r) if (crow(r, hi) > r32) X0[r] = 0.f;
        } else {
#pragma unroll
            for (int r = 0; r < 16; ++r) if (crow(r, hi) > r32) X1[r] = 0.f;
        }
        bf16x8 vf[4];
#pragma unroll
        for (int ss = 0; ss < 4; ++ss) vf[ss] = trfrag(VT, A, ss, sl);
        f32x16 o = (f32x16){0.f, 0.f, 0.f, 0.f, 0.f, 0.f, 0.f, 0.f, 0.f, 0.f, 0.f, 0.f, 0.f, 0.f, 0.f, 0.f};
#pragma unroll
        for (int s2 = 0; s2 < 2; ++s2) { v4u w; w.x = cvtpk(X0[8 * s2], X0[8 * s2 + 1]); w.y = cvtpk(X0[8 * s2 + 2], X0[8 * s2 + 3]); w.z = cvtpk(X0[8 * s2 + 4], X0[8 * s2 + 5]); w.w = cvtpk(X0[8 * s2 + 6], X0[8 * s2 + 7]);
            o = __builtin_amdgcn_mfma_f32_32x32x16_bf16(__builtin_bit_cast(bf16x8, w), vf[s2], o, 0, 0, 0); }
        if (th == 1) {
#pragma unroll
            for (int s2 = 0; s2 < 2; ++s2) { v4u w; w.x = cvtpk(X1[8 * s2], X1[8 * s2 + 1]); w.y = cvtpk(X1[8 * s2 + 2], X1[8 * s2 + 3]); w.z = cvtpk(X1[8 * s2 + 4], X1[8 * s2 + 5]); w.w = cvtpk(X1[8 * s2 + 6], X1[8 * s2 + 7]);
                o = __builtin_amdgcn_mfma_f32_32x32x16_bf16(__builtin_bit_cast(bf16x8, w), vf[2 + s2], o, 0, 0, 0); }
        }
#pragma unroll
        for (int kk = 0; kk < 8; ++kk) {
            const int kb = kk >> 1, s2 = kk & 1;
            v4u w; w.x = cvtpk(st[kb][8 * s2], st[kb][8 * s2 + 1]); w.y = cvtpk(st[kb][8 * s2 + 2], st[kb][8 * s2 + 3]); w.z = cvtpk(st[kb][8 * s2 + 4], st[kb][8 * s2 + 5]); w.w = cvtpk(st[kb][8 * s2 + 6], st[kb][8 * s2 + 7]);
            LAS const unsigned char* qrow = QT + (32 * th + r32) * 256 + 8 * hi;
            const v2u q0 = *(LAS const v2u*)(qrow + (((2 * kk) ^ swq) << 4)), q1 = *(LAS const v2u*)(qrow + (((2 * kk + 1) ^ swq) << 4));
            const v4u qa = (v4u){q0.x, q0.y, q1.x, q1.y};
            o = __builtin_amdgcn_mfma_f32_32x32x16_bf16(__builtin_bit_cast(bf16x8, qa), __builtin_bit_cast(bf16x8, w), o, 0, 0, 0);
        }
#pragma unroll
        for (int ss = 0; ss < 4; ++ss)
#pragma unroll
            for (int kb = 0; kb < 4; ++kb) { const bf16x8 afr = trfrag(KT, A, ss, kb); st[kb] = __builtin_amdgcn_mfma_f32_32x32x16_bf16(afr, vf[ss], st[kb], 0, 0, 0); }
#pragma unroll
        for (int kb = 0; kb < 4; ++kb)
#pragma unroll
            for (int g4 = 0; g4 < 4; ++g4) { const f32x4 d4 = *(LAS const f32x4*)(hds + c * 128 + 32 * kb + 8 * g4 + 4 * hi);
                st[kb][4 * g4] *= d4.x; st[kb][4 * g4 + 1] *= d4.y; st[kb][4 * g4 + 2] *= d4.z; st[kb][4 * g4 + 3] *= d4.w; }
        LAS float* ost = (LAS float*)(lds + OST);
#pragma unroll
        for (int r = 0; r < 16; ++r) ost[(32 * th + crow(r, hi)) * 128 + 32 * sl + r32] = o[r];
        asm volatile("s_waitcnt lgkmcnt(0)\n\ts_barrier" ::: "memory");
        {
            const int row = 8 * wave + (lane >> 3), c0 = (lane & 7) * 16;
            float v[16]; float ss = 0.f;
#pragma unroll
            for (int e4 = 0; e4 < 4; ++e4) { const f32x4 x = *(LAS const f32x4*)(ost + row * 128 + c0 + 4 * e4); v[4 * e4] = x.x; v[4 * e4 + 1] = x.y; v[4 * e4 + 2] = x.z; v[4 * e4 + 3] = x.w;
                ss += (x.x * x.x + x.y * x.y) + (x.z * x.z + x.w * x.w); }
            ss += __shfl_xor(ss, 1); ss += __shfl_xor(ss, 2); ss += __shfl_xor(ss, 4);
            const float rn = rsqrtf(ss * (1.f / 128.f) + EPS);
            const size_t trow = t0 + (size_t)c * 64 + row;
            const unsigned gw[8] = {g0.x, g0.y, g0.z, g0.w, g1.x, g1.y, g1.z, g1.w};
            unsigned ow[8];
#pragma unroll
            for (int e = 0; e < 8; ++e) { const float a = v[2 * e] * rn * go[2 * e] * bflo(gw[e]), bb = v[2 * e + 1] * rn * go[2 * e + 1] * bfhi(gw[e]); ow[e] = pk2(a, bb); }
            bf16* op = CAT + trow * D + 512 + h * 128 + c0;
            *(GAS v4u*)op = (v4u){ow[0], ow[1], ow[2], ow[3]}; *(GAS v4u*)(op + 8) = (v4u){ow[4], ow[5], ow[6], ow[7]};
        }
    }
    HG_WAITBAR(0);
#undef HGC_ISSUE
}
}
struct EpiBf16 {
    static constexpr bool PERM = true, AFTER_DRAIN = false, LDS_SCALE = false;
    bf16* O; int ldc;
    __device__ __forceinline__ void operator()(const pg8::f32x4 (&acc)[2][2][4][2], const pg8::Unit& u, int wr, int wc, int fr, int fq) const {
        const int row0 = u.pm * 256 + wr * 64 + fr, col0 = u.pn * 256 + wc * 32 + 8 * fq;
#pragma unroll
        for (int ai = 0; ai < 2; ++ai)
#pragma unroll
            for (int m = 0; m < 4; ++m) { bf16* rowp = O + (size_t)(row0 + ai * 128 + m * 16) * ldc + col0;
#pragma unroll
                for (int bj = 0; bj < 2; ++bj) { const pg8::f32x4 v0 = acc[ai][bj][m][0], v1 = acc[ai][bj][m][1];
                    v4u w; w.x = pk2(v0[0], v0[1]); w.y = pk2(v0[2], v0[3]); w.z = pk2(v1[0], v1[1]); w.w = pk2(v1[2], v1[3]);
                    *(GAS v4u*)(rowp + bj * 128) = w; } }
    }
};
struct EpiBf16I8 {
    static constexpr bool PERM = true, AFTER_DRAIN = false, LDS_SCALE = true;
    __device__ __forceinline__ const float* scale_base(const pg8::Unit& u, int wid) const { return wid < 4 ? RS + u.pm * 256 + wid * 64 : CS + u.pn * 256 + (wid - 4) * 64; }
    bf16* O; int ldc; const float* RS; const float* CS;
    __device__ __forceinline__ void operator()(const pg8::f32x4 (&acc)[2][2][4][2], const pg8::Unit& u, int wr, int wc, int fr, int fq, const LAS float* scl) const {
        const int row0 = u.pm * 256 + wr * 64 + fr, col0 = u.pn * 256 + wc * 32 + 8 * fq;
        f32x2 c2[2][4];
#pragma unroll
        for (int bj = 0; bj < 2; ++bj)
#pragma unroll
            for (int q = 0; q < 4; ++q) c2[bj][q] = (f32x2){scl[256 + bj * 128 + wc * 32 + 8 * fq + 2 * q], scl[256 + bj * 128 + wc * 32 + 8 * fq + 2 * q + 1]};
#pragma unroll
        for (int ai = 0; ai < 2; ++ai)
#pragma unroll
            for (int m = 0; m < 4; ++m) { const float rs = scl[wr * 64 + fr + ai * 128 + m * 16] * (1.f / 127.f); bf16* rowp = O + (size_t)(row0 + ai * 128 + m * 16) * ldc + col0;
                const f32x2 rs2 = (f32x2){rs, rs};
#pragma unroll
                for (int bj = 0; bj < 2; ++bj) { const pg8::i32x4 i0 = __builtin_bit_cast(pg8::i32x4, acc[ai][bj][m][0]), i1 = __builtin_bit_cast(pg8::i32x4, acc[ai][bj][m][1]);
                    const f32x2 e0 = (f32x2){(float)i0[0], (float)i0[1]} * rs2 * c2[bj][0], e1 = (f32x2){(float)i0[2], (float)i0[3]} * rs2 * c2[bj][1];
                    const f32x2 e2 = (f32x2){(float)i1[0], (float)i1[1]} * rs2 * c2[bj][2], e3 = (f32x2){(float)i1[2], (float)i1[3]} * rs2 * c2[bj][3];
                    v4u w; w.x = pk2(e0.x, e0.y); w.y = pk2(e1.x, e1.y); w.z = pk2(e2.x, e2.y); w.w = pk2(e3.x, e3.y);
                    *(GAS v4u*)(rowp + bj * 128) = w; } }
    }
};
__device__ __forceinline__ void p_mid(Frame& F) {
    const int gw = F.vcu * NWAVES + F.wave, NGW = F.G * NWAVES;
    const float* x = F.in[I_X]; const float* gpost = F.in[I_GPOST1]; const float* gpre = F.in[I_GPRE2];
    const float* mod = (const float*)(F.ws + WS_MOD); const bf16* Y = (const bf16*)(F.ws + WS_Y);
    f32x4 pgg[4], pgt[4], pg2[4], psc[4], psh[4];
    { const float* mb = mod + ((16 * gw) / S) * NMOD;
#pragma unroll
      for (int j = 0; j < 4; ++j) { const int col = (F.lane + 64 * j) * 4; pgg[j] = *(const f32x4*)(gpost + col); pgt[j] = *(const f32x4*)(mb + 2 * D + col);
          pg2[j] = *(const f32x4*)(gpre + col); psc[j] = 1.f + *(const f32x4*)(mb + 4 * D + col); psh[j] = *(const f32x4*)(mb + 3 * D + col); } }
#pragma unroll 1
    for (int m0 = 16 * gw; m0 < 16 * gw + 16; m0 += 4) {
        f32x4 xv[4][4]; v2u yw[4][4];
#pragma unroll
        for (int q = 0; q < 4; ++q) { const GAS f32x4* xr = (const GAS f32x4*)(x + (size_t)(m0 + q) * D) + F.lane; const GAS v2u* yr = (const GAS v2u*)(Y + (size_t)(m0 + q) * D) + F.lane;
#pragma unroll
            for (int j = 0; j < 4; ++j) { xv[q][j] = __builtin_nontemporal_load(xr + 64 * j); yw[q][j] = __builtin_nontemporal_load(yr + 64 * j); } }
#pragma unroll
        for (int q = 0; q < 4; ++q) {
            const int m = m0 + q;
            f32x4 yv[4]; float ss = 0.f;
#pragma unroll
            for (int j = 0; j < 4; ++j) { const v2u w = yw[q][j]; yv[j] = (f32x4){bflo(w.x), bfhi(w.x), bflo(w.y), bfhi(w.y)};
                ss += (yv[j].x * yv[j].x + yv[j].y * yv[j].y) + (yv[j].z * yv[j].z + yv[j].w * yv[j].w); }
            const float r = rsqrtf(wave_sum_fast(ss) * (1.f / D) + EPS);
            float s2 = 0.f;
#pragma unroll
            for (int j = 0; j < 4; ++j) {
                xv[q][j] = xv[q][j] + pgt[j] * yv[j] * r * pgg[j];
                *((GAS v2u*)(F.ws + WS_X1B + (size_t)m * D * 2) + F.lane + 64 * j) = (v2u){pk2(xv[q][j].x, xv[q][j].y), pk2(xv[q][j].z, xv[q][j].w)};
                s2 += (xv[q][j].x * xv[q][j].x + xv[q][j].y * xv[q][j].y) + (xv[q][j].z * xv[q][j].z + xv[q][j].w * xv[q][j].w); }
            const float r2 = rsqrtf(wave_sum_fast(s2) * (1.f / D) + EPS);
            float am = 0.f;
#pragma unroll
            for (int j = 0; j < 4; ++j) {
                const f32x4 y = xv[q][j] * r2 * pg2[j] * psc[j] + psh[j]; xv[q][j] = y;
                am = fmaxf(am, fmaxf(fmaxf(fabsf(y.x), fabsf(y.y)), fmaxf(fabsf(y.z), fabsf(y.w)))); }
            am = fmaxf(wave_max_fast(am), 1e-30f);
            const float inv = 127.f / am;
            GAS unsigned* h8 = (GAS unsigned*)(F.ws + WS_H8 + (size_t)m * D) + F.lane;
#pragma unroll
            for (int j = 0; j < 4; ++j) { const int q0 = (int)rintf(xv[q][j].x * inv), q1 = (int)rintf(xv[q][j].y * inv), q2 = (int)rintf(xv[q][j].z * inv), q3 = (int)rintf(xv[q][j].w * inv);
                h8[64 * j] = (unsigned)(q0 & 255) | ((unsigned)(q1 & 255) << 8) | ((unsigned)(q2 & 255) << 16) | ((unsigned)(q3 & 255) << 24); }
            if (F.lane == 0) ((float*)(F.ws + WS_HS))[m] = am * (1.f / 127.f);
        }
    }
}
namespace topk {
using attn::crow;
__device__ __forceinline__ float keyf(float v, unsigned clr, unsigned code) { return __builtin_bit_cast(float, (__builtin_bit_cast(unsigned, v) & ~clr) | code); }
__device__ __forceinline__ float keyval(float k, unsigned clr) { return __builtin_bit_cast(float, __builtin_bit_cast(unsigned, k) & ~clr); }
__device__ __forceinline__ unsigned keycode(float k, unsigned clr) { return __builtin_bit_cast(unsigned, k) & clr; }
__device__ __forceinline__ void cas_desc(float& a, float& b) { const float hi = fmaxf(a, b), lo = fminf(a, b); a = hi; b = lo; }
struct Net16 { int i[63], j[63]; };
constexpr Net16 make_net16() { Net16 n{}; const int p[63][2] = {{0,1},{2,3},{0,2},{1,3},{1,2},{4,5},{6,7},{4,6},{5,7},{5,6},{0,4},{2,6},{2,4},{1,5},{3,7},{3,5},{1,2},{3,4},{5,6},{8,9},{10,11},{8,10},{9,11},{9,10},{12,13},{14,15},{12,14},{13,15},{13,14},{8,12},{10,14},{10,12},{9,13},{11,15},{11,13},{9,10},{11,12},{13,14},{0,8},{4,12},{4,8},{2,10},{6,14},{6,10},{2,4},{6,8},{10,12},{1,9},{5,13},{5,9},{3,11},{7,15},{7,11},{3,5},{7,9},{11,13},{1,2},{3,4},{5,6},{7,8},{9,10},{11,12},{13,14}};
    for (int k = 0; k < 63; ++k) { n.i[k] = p[k][0]; n.j[k] = p[k][1]; } return n; }
constexpr Net16 NET16 = make_net16();
template <int OFF> __device__ __forceinline__ void sort16_desc(float (&a)[64]) {
#pragma unroll
    for (int k = 0; k < 63; ++k) cas_desc(a[OFF + NET16.i[k]], a[OFF + NET16.j[k]]);
}
template <int OFF> __device__ __forceinline__ void merge16_desc(float (&a)[64]) {
#pragma unroll
    for (int j = 8; j > 0; j >>= 1)
#pragma unroll
        for (int i = 0; i < 16; ++i) { const int l = i ^ j; if (l > i) cas_desc(a[OFF + i], a[OFF + l]); }
}
template <int A, int B> __device__ __forceinline__ void top16(float (&a)[64]) {
#pragma unroll
    for (int i = 0; i < 16; ++i) a[A + i] = fmaxf(a[A + i], a[B + 15 - i]);
    merge16_desc<A>(a);
}
__device__ __forceinline__ void xlane_top16(float (&a)[64]) {
#pragma unroll
    for (int i = 0; i < 16; ++i) a[16 + i] = __shfl_xor(a[i], 32);
    top16<0, 16>(a);
}
struct Stair { int a[50], b[50]; };
constexpr Stair make_stair() { Stair s{}; int n = 0; for (int a = 0; a < 16; ++a) for (int b = 0; b < 16; ++b) if ((a + 1) * (b + 1) <= 16) { s.a[n] = a; s.b[n] = b; ++n; } return s; }
constexpr Stair STAIR = make_stair();

__device__ __forceinline__ void q_dma(const bf16* qblk  , unsigned qdst, int lane) {
#pragma unroll
    for (int j = 0; j < 8; ++j) { const int row = 4 * j + (lane >> 4), c = (lane & 15) ^ (row & 15);
        glds16(qblk + (size_t)row * NPQ + 8 * c, qdst + j * 1024); }
}
__device__ __forceinline__ void q_frag(LAS const unsigned char* qb, int r32, int hi, bf16x8 (&bq)[8]) {
    asm volatile("s_waitcnt vmcnt(0)" ::: "memory");
#pragma unroll
    for (int kk = 0; kk < 8; ++kk) bq[kk] = *(LAS const bf16x8*)(qb + r32 * 256 + (((2 * kk + hi) ^ (r32 & 15)) << 4));
    LDS_WAIT(); asm volatile("" ::: "memory");
}
__device__ __forceinline__ void half_top16(const bf16x8 (&bq)[8], LAS const unsigned char* kimg, int r32, int hi, float (&val)[16], int (&idx)[16]) {
    f32x16 acc[4];
#pragma unroll
    for (int kb = 0; kb < 4; ++kb) acc[kb] = (f32x16){0.f, 0.f, 0.f, 0.f, 0.f, 0.f, 0.f, 0.f, 0.f, 0.f, 0.f, 0.f, 0.f, 0.f, 0.f, 0.f};
    const int sw = ((r32 & 3) << 2) | ((r32 >> 2) & 3);
#pragma unroll
    for (int kk = 0; kk < 8; ++kk)
#pragma unroll
        for (int kb = 0; kb < 4; ++kb) { const bf16x8 ak = *(LAS const bf16x8*)(kimg + (32 * kb + r32) * 256 + (((2 * kk + hi) ^ sw) << 4));
            acc[kb] = __builtin_amdgcn_mfma_f32_32x32x16_bf16(ak, bq[kk], acc[kb], 0, 0, 0); }
    float a[64];
    const unsigned h4 = 4u * (unsigned)hi;
#pragma unroll
    for (int kb = 0; kb < 4; ++kb)
#pragma unroll
        for (int r = 0; r < 16; ++r) a[16 * kb + r] = keyf(acc[kb][r], 127u, (unsigned)(127 - 32 * kb - (r & 3) - 8 * (r >> 2)) - h4);
    sort16_desc<0>(a); sort16_desc<16>(a); sort16_desc<32>(a); sort16_desc<48>(a);
    top16<0, 16>(a); top16<32, 48>(a); top16<0, 32>(a);
    xlane_top16(a);
#pragma unroll
    for (int i = 0; i < 16; ++i) { val[i] = keyval(a[i], 127u); idx[i] = 127 - (int)keycode(a[i], 127u); }
}
__device__ __forceinline__ void phase(Frame& F) {
    LAS unsigned char* lds = F.lds + RING_OFF;
    const int lane = F.lane, wave = F.wave, r32 = lane & 31, hi = lane >> 5;
    const int hd = F.vcu & 7, grp = F.vcu >> 3;
    const bf16* Q = (const bf16*)(F.ws + WS_Q);
    int* pidx = (int*)(F.ws + WS_PIDX); float* pgate = (float*)(F.ws + WS_PGATE);
    { const unsigned char* kb = (const unsigned char*)(F.ws + WS_KEYS) + (size_t)hd * 2 * 32768;
#pragma unroll
      for (int i = 0; i < 8; ++i) { const int p = wave * 8 + i, row = 4 * (p & 31) + (lane >> 4), chp = lane & 15, sw = ((row & 3) << 2) | ((row >> 2) & 3);
          __builtin_amdgcn_global_load_lds((const unsigned*)(kb + (size_t)(p >> 5) * 32768 + row * 256 + ((chp ^ sw) << 4)), (LAS unsigned*)(lds + p * 1024), 16, 0, 0); }
      asm volatile("s_waitcnt vmcnt(0)\n\ts_barrier" ::: "memory"); }
    LAS unsigned char* tab = F.lds + TOPK_TAB_OFF + wave * 2048 + lane;
    LAS const unsigned char* qb = lds + 65536 + wave * 8192;
    const unsigned qdst = lds_addr(qb);
    q_dma(Q + (size_t)(((grp * 32) + wave * 4) * 32) * NPQ + hd * 256, qdst, lane);
    for (int it = 0; it < 4; ++it) {
        const int t0 = ((grp * 32) + wave * 4 + it) * 32, t0n = ((grp * 32) + wave * 4 + (it < 3 ? it + 1 : 3)) * 32;
        float v1[16], v2[16]; int i1[16], i2[16];
        { bf16x8 bq[8]; q_frag(qb, r32, hi, bq);
          q_dma(Q + (size_t)t0 * NPQ + hd * 256 + 128, qdst, lane);
          half_top16(bq, lds, r32, hi, v1, i1); }
        { bf16x8 bq[8]; q_frag(qb, r32, hi, bq);
          q_dma(Q + (size_t)t0n * NPQ + hd * 256, qdst, lane);
          half_top16(bq, lds + 32768, r32, hi, v2, i2); }
#pragma unroll
        for (int i = 0; i < 16; ++i) { tab[i * 64] = (unsigned char)i1[i]; tab[(16 + i) * 64] = (unsigned char)i2[i]; }
        float c[64];
#pragma unroll
        for (int n = 0; n < 32; ++n) {
            if (n < 25) { const int a0 = STAIR.a[2 * n], b0 = STAIR.b[2 * n], a1 = STAIR.a[2 * n + 1], b1 = STAIR.b[2 * n + 1];
                const float k0 = keyf(v1[a0] + v2[b0], 255u, (unsigned)(255 - (a0 * 16 + b0))), k1 = keyf(v1[a1] + v2[b1], 255u, (unsigned)(255 - (a1 * 16 + b1)));
                c[n] = hi ? k1 : k0; }
            else c[n] = -INFINITY;
        }
        sort16_desc<0>(c); sort16_desc<16>(c); top16<0, 16>(c); xlane_top16(c);
        LDS_WAIT();
        {
            int ex[16];
#pragma unroll
            for (int i = 0; i < 16; ++i) { const int pos = 255 - (int)keycode(c[i], 255u); ex[i] = (int)tab[(pos >> 4) * 64] * 128 + (int)tab[(16 + (pos & 15)) * 64]; }
            const float mx = keyval(c[0], 255u); float e[16], s = 0.f;
#pragma unroll
            for (int i = 0; i < 16; ++i) { e[i] = __expf(keyval(c[i], 255u) - mx); s += e[i]; }
            const float inv = 1.f / s;
            unsigned w[16];
#pragma unroll
            for (int i = 0; i < 16; ++i) w[i] = hi ? __builtin_bit_cast(unsigned, e[i] * inv) : (unsigned)ex[i];
            unsigned* dst = (hi ? (unsigned*)pgate : (unsigned*)pidx) + (size_t)(t0 + r32) * 128 + hd * 16;
#pragma unroll
            for (int g4 = 0; g4 < 4; ++g4) *(GAS v4u*)(dst + 4 * g4) = (v4u){w[4 * g4], w[4 * g4 + 1], w[4 * g4 + 2], w[4 * g4 + 3]};
        }
        LDS_WAIT();
    }
    asm volatile("s_waitcnt vmcnt(0) lgkmcnt(0)\n\ts_barrier" ::: "memory");
}
}
namespace peer {
typedef float f32x2 __attribute__((ext_vector_type(2)));
template <int CTRL> __device__ __forceinline__ int dpp_i(int v) { return __builtin_amdgcn_update_dpp(0, v, CTRL, 0xf, 0xf, true); }
__device__ __forceinline__ int dot16(const v4u u, const v4u h) {
    int acc = __builtin_amdgcn_sdot4((int)u.x, (int)h.x, 0, false);
    acc = __builtin_amdgcn_sdot4((int)u.y, (int)h.y, acc, false);
    acc = __builtin_amdgcn_sdot4((int)u.z, (int)h.z, acc, false);
    return __builtin_amdgcn_sdot4((int)u.w, (int)h.w, acc, false);
}
__device__ __forceinline__ void axpy4(f32x2 (&y)[8], int o, unsigned v, float w) {
    const f32x2 ww = (f32x2){w, w};
    y[o] += ww * (f32x2){(float)(v & 0xff), (float)((v >> 8) & 0xff)};
    y[o + 1] += ww * (f32x2){(float)((v >> 16) & 0xff), (float)(v >> 24)};
}
constexpr int PF = 16;
constexpr int TOKWG = 128;
__device__ __forceinline__ void phase(Frame& F) {
    const int lane = F.lane, wave = F.wave, g = lane >> 3, sub = lane & 7;
    const int x = F.vcu >> 5, tokbase = F.vcu * TOKWG;
    LAS int* IDX = (LAS int*)(F.lds + RING_OFF);
    LAS int* AT = (LAS int*)(F.lds + RING_OFF + 65536);
    LAS float* WT = (LAS float*)(F.lds + LDSCTL_OFF + 4096);
    const unsigned char* EU = (const unsigned char*)(F.ws + WS_EU8); const unsigned char* EV = (const unsigned char*)(F.ws + WS_EV8);
    const f32x2* SUV = (const f32x2*)(F.ws + WS_SU); const float* HS = (const float*)(F.ws + WS_HS);
    const int* pidx = (const int*)(F.ws + WS_PIDX); const float* pgate = (const float*)(F.ws + WS_PGATE);
    bf16* Y2 = (bf16*)(F.ws + WS_Y2);
    for (int i = F.tid; i < TOKWG * 128; i += NWAVES * 64) { const int tl = i >> 7, k = i & 127; IDX[tl * 128 + ((k + 4 * (tl & 7)) & 127)] = pidx[(size_t)tokbase * 128 + i]; }
    __syncthreads();
    const int skew = 4 * g;
    for (int s = 0; s < 8; ++s) {
        const int sl = (x + s) & 7;
#pragma unroll 1
        for (int rd = 0; rd < 2; ++rd) {
            const int tl = rd * 64 + wave * 8 + g, t = tokbase + tl;
            const v4u hreg = *(const GAS v4u*)(F.ws + WS_H8 + (size_t)t * D + 128 * sl + 16 * sub);
            const unsigned eo = (unsigned)(128 * sl + 16 * sub);
            LAS const int* irow = IDX + tl * 128; LAS int* arow = AT + tl * 128;
            v4u ub[PF];
            { unsigned idn[PF];
#pragma unroll
              for (int j = 0; j < PF / 4; ++j) { const v4u q = *(LAS const v4u*)(irow + ((4 * j + skew) & 127)); idn[4 * j] = q.x; idn[4 * j + 1] = q.y; idn[4 * j + 2] = q.z; idn[4 * j + 3] = q.w; }
#pragma unroll
              for (int i = 0; i < PF; ++i) ub[i] = *(const GAS v4u*)(EU + ((idn[i] << 10) + eo)); }
#pragma unroll 1
            for (int k0 = 0; k0 < 128; k0 += PF) {
                const int kn = (k0 + PF < 128) ? k0 + PF : 128 - PF;
                unsigned idn[PF];
#pragma unroll
                for (int j = 0; j < PF / 4; ++j) { const v4u q = *(LAS const v4u*)(irow + ((kn + 4 * j + skew) & 127)); idn[4 * j] = q.x; idn[4 * j + 1] = q.y; idn[4 * j + 2] = q.z; idn[4 * j + 3] = q.w; }
                int coll[PF / 8];
#pragma unroll
                for (int c = 0; c < PF / 8; ++c) coll[c] = 0;
#pragma unroll
                for (int i = 0; i < PF; ++i) {
                    int d = dot16(ub[i], hreg);
                    ub[i] = *(const GAS v4u*)(EU + ((idn[i] << 10) + eo));
                    d += dpp_i<0xB1>(d); d += dpp_i<0x4E>(d); d += dpp_i<0x141>(d);
                    coll[i >> 3] = (sub == (i & 7)) ? d : coll[i >> 3];
                }
#pragma unroll
                for (int c = 0; c < PF / 8; ++c) { const int pos = (k0 + 8 * c + sub + skew) & 127; arow[pos] = (s == 0) ? coll[c] : arow[pos] + coll[c]; }
            }
        }
    }
    LDS_WAIT();
#pragma unroll 1
    for (int t4 = 0; t4 < 16; t4 += 4) {
        int e[4][2], pos[4][2]; float gv[4][2], suv[4][2], svv[4][2], hsv[4]; int av[4][2];
#pragma unroll
        for (int u = 0; u < 4; ++u) { const int tt = t4 + u, tl = (tt >> 3) * 64 + wave * 8 + (tt & 7), t = tokbase + tl; hsv[u] = HS[t];
#pragma unroll
            for (int hh = 0; hh < 2; ++hh) { const int k = hh * 64 + lane; pos[u][hh] = tl * 128 + ((k + 4 * (tl & 7)) & 127); e[u][hh] = IDX[pos[u][hh]]; av[u][hh] = AT[pos[u][hh]]; gv[u][hh] = pgate[(size_t)t * 128 + k]; } }
#pragma unroll
        for (int u = 0; u < 4; ++u)
#pragma unroll
            for (int hh = 0; hh < 2; ++hh) { const f32x2 s2 = SUV[e[u][hh]]; suv[u][hh] = s2.x; svv[u][hh] = s2.y; }
        LDS_WAIT();
#pragma unroll
        for (int u = 0; u < 4; ++u) { const int tt = t4 + u, tl = (tt >> 3) * 64 + wave * 8 + (tt & 7); float w[2];
#pragma unroll
            for (int hh = 0; hh < 2; ++hh) { const float af = (float)av[u][hh] * suv[u][hh] * hsv[u];
                w[hh] = gv[u][hh] * 0.5f * af * (1.f + erff(af * 0.70710678118654752f)) * svv[u][hh]; }
            const float wmax = wave_max_fast(fmaxf(fabsf(w[0]), fabsf(w[1])));
            const float inv = wmax > 0.f ? 127.f / wmax : 0.f;
            LAS signed char* wq = (LAS signed char*)(AT + tl * 128);
#pragma unroll
            for (int hh = 0; hh < 2; ++hh) wq[(hh * 64 + lane + 16 * (tl & 7)) & 127] = (signed char)(int)rintf(w[hh] * inv);
            if (lane == 0) WT[tl] = wmax * (1.f / 127.f); }
    }
    LDS_WAIT();
    float ssq[2] = {0.f, 0.f};
    for (int s = 0; s < 8; ++s) {
        const int sl = (x + s) & 7;
#pragma unroll
        for (int rd = 0; rd < 2; ++rd) {
            const int tl = rd * 64 + wave * 8 + g, t = tokbase + tl;
            const unsigned eo = (unsigned)(128 * sl + 16 * sub);
            LAS const int* irow = IDX + tl * 128; LAS const unsigned char* wrow = (LAS const unsigned char*)(AT + tl * 128);
            int acc[16];
#pragma unroll
            for (int i = 0; i < 16; ++i) acc[i] = 0;
            v4u ub[PF];
            { unsigned idn[PF];
#pragma unroll
              for (int j = 0; j < PF / 4; ++j) { const v4u q = *(LAS const v4u*)(irow + ((4 * j + skew) & 127)); idn[4 * j] = q.x; idn[4 * j + 1] = q.y; idn[4 * j + 2] = q.z; idn[4 * j + 3] = q.w; }
#pragma unroll
              for (int i = 0; i < PF; ++i) ub[i] = *(const GAS v4u*)(EV + ((idn[i] << 10) + eo)); }
#pragma unroll 1
            for (int k0 = 0; k0 < 128; k0 += PF) {
                const int kn = (k0 + PF < 128) ? k0 + PF : 128 - PF;
                unsigned idn[PF];
#pragma unroll
                for (int j = 0; j < PF / 4; ++j) { const v4u q = *(LAS const v4u*)(irow + ((kn + 4 * j + skew) & 127)); idn[4 * j] = q.x; idn[4 * j + 1] = q.y; idn[4 * j + 2] = q.z; idn[4 * j + 3] = q.w; }
                const v4u wq4 = *(LAS const v4u*)(wrow + ((k0 + 16 * g) & 127));
                const unsigned wqa[4] = {wq4.x, wq4.y, wq4.z, wq4.w};
#pragma unroll
                for (int j = 0; j < PF / 4; ++j) {
                    const v4u r0 = ub[4 * j], r1 = ub[4 * j + 1], r2 = ub[4 * j + 2], r3 = ub[4 * j + 3];
#pragma unroll
                    for (int i = 0; i < 4; ++i) ub[4 * j + i] = *(const GAS v4u*)(EV + ((idn[4 * j + i] << 10) + eo));
                    const unsigned c0[4] = {r0.x, r0.y, r0.z, r0.w}, c1[4] = {r1.x, r1.y, r1.z, r1.w}, c2[4] = {r2.x, r2.y, r2.z, r2.w}, c3[4] = {r3.x, r3.y, r3.z, r3.w};
#pragma unroll
                    for (int q = 0; q < 4; ++q) {
                        const unsigned lo01 = __builtin_amdgcn_perm(c1[q], c0[q], 0x05010400u), hi01 = __builtin_amdgcn_perm(c1[q], c0[q], 0x07030602u);
                        const unsigned lo23 = __builtin_amdgcn_perm(c3[q], c2[q], 0x05010400u), hi23 = __builtin_amdgcn_perm(c3[q], c2[q], 0x07030602u);
                        const unsigned t0 = __builtin_amdgcn_perm(lo23, lo01, 0x05040100u), t1 = __builtin_amdgcn_perm(lo23, lo01, 0x07060302u);
                        const unsigned t2 = __builtin_amdgcn_perm(hi23, hi01, 0x05040100u), t3 = __builtin_amdgcn_perm(hi23, hi01, 0x07060302u);
                        acc[4 * q] = __builtin_amdgcn_sdot4((int)t0, (int)wqa[j], acc[4 * q], false);
                        acc[4 * q + 1] = __builtin_amdgcn_sdot4((int)t1, (int)wqa[j], acc[4 * q + 1], false);
                        acc[4 * q + 2] = __builtin_amdgcn_sdot4((int)t2, (int)wqa[j], acc[4 * q + 2], false);
                        acc[4 * q + 3] = __builtin_amdgcn_sdot4((int)t3, (int)wqa[j], acc[4 * q + 3], false);
                    }
                }
            }
            const float sc = WT[tl]; float y[16]; float sq = 0.f;
#pragma unroll
            for (int i = 0; i < 16; ++i) { y[i] = (float)acc[i] * sc; sq += y[i] * y[i]; }
            ssq[rd] += sq;
            bf16* yp = Y2 + (size_t)t * D + 128 * sl + 16 * sub;
#pragma unroll
            for (int q8 = 0; q8 < 2; ++q8) __builtin_nontemporal_store((v4u){pk2(y[8 * q8], y[8 * q8 + 1]), pk2(y[8 * q8 + 2], y[8 * q8 + 3]), pk2(y[8 * q8 + 4], y[8 * q8 + 5]), pk2(y[8 * q8 + 6], y[8 * q8 + 7])}, (v4u*)(yp + 8 * q8));
        }
    }
#pragma unroll
    for (int rd = 0; rd < 2; ++rd) { float v = ssq[rd]; v += dpp_f<0xB1>(v); v += dpp_f<0x4E>(v); v += dpp_f<0x141>(v); if (sub == 0) WT[rd * 64 + wave * 8 + g] = v; }
    asm volatile("s_waitcnt vmcnt(0) lgkmcnt(0)" ::: "memory");
    const float* mod = (const float*)(F.ws + WS_MOD); const float* gp1 = F.in[I_GPOST1]; const float* gp2 = F.in[I_GPOST2];
    const float* R1 = (const float*)(F.ws + WS_R1); const bf16* Y1 = (const bf16*)(F.ws + WS_Y);
    f32x4 q2[4];
    { const float* mb = mod + (tokbase / S) * NMOD;
#pragma unroll
      for (int j = 0; j < 4; ++j) { const int col = (lane + 64 * j) * 4; q2[j] = *(const f32x4*)(mb + 5 * D + col) * *(const f32x4*)(gp2 + col); } }
    const bf16* X1 = (const bf16*)(F.ws + WS_X1B);
#pragma unroll 1
    for (int t2 = 0; t2 < 16; t2 += 4) {
        v2u xv[4][4], zv[4][4];
#pragma unroll
        for (int u = 0; u < 4; ++u) { const int tt = t2 + u, tl = (tt >> 3) * 64 + wave * 8 + (tt & 7), m = tokbase + tl;
#pragma unroll
            for (int j = 0; j < 4; ++j) { xv[u][j] = __builtin_nontemporal_load((const GAS v2u*)(X1 + (size_t)m * D) + lane + 64 * j);
                zv[u][j] = __builtin_nontemporal_load((const GAS v2u*)(Y2 + (size_t)m * D) + lane + 64 * j); } }
#pragma unroll
        for (int u = 0; u < 4; ++u) { const int tt = t2 + u, tl = (tt >> 3) * 64 + wave * 8 + (tt & 7), m = tokbase + tl;
            const float r2 = rsqrtf(WT[tl] * (1.f / D) + EPS);
#pragma unroll
            for (int j = 0; j < 4; ++j) {
                const f32x4 x1 = (f32x4){bflo(xv[u][j].x), bfhi(xv[u][j].x), bflo(xv[u][j].y), bfhi(xv[u][j].y)};
                const f32x4 y2 = (f32x4){bflo(zv[u][j].x), bfhi(zv[u][j].x), bflo(zv[u][j].y), bfhi(zv[u][j].y)};
                __builtin_nontemporal_store(x1 + q2[j] * y2 * r2, (GAS f32x4*)(F.out + (size_t)m * D) + lane + 64 * j); } }
    }
    __syncthreads();
}
}
struct Args { const float* in[18]; float* out; unsigned char* ws; int ph_lo, ph_hi; };
__global__ void __launch_bounds__(NWAVES * 64, 2) mega(Args args) {
    extern __shared__ __attribute__((aligned(16))) unsigned char lds[];
    Frame F;
    F.lds = (LAS unsigned char*)lds;
    F.MISC = (volatile LAS unsigned*)(F.lds + MISC_OFF);
    F.tid = threadIdx.x; F.lane = F.tid & 63; F.wave = __builtin_amdgcn_readfirstlane(F.tid >> 6);
    F.G = gridDim.x; { const int bx = blockIdx.x; F.vcu = (F.G % 8 == 0) ? (bx % 8) * (F.G / 8) + bx / 8 : bx; }
    F.in = args.in; F.out = args.out; F.ws = args.ws;
    F.ctl = (gu32*)(args.ws + WS_CTL);
    for (int u = F.tid; u < (LDS_BYTES - LDSCTL_OFF) / 4; u += NWAVES * 64) ((LAS unsigned*)(F.lds + LDSCTL_OFF))[u] = 0u;
    __syncthreads();
    const int lo = args.ph_lo, hi = args.ph_hi;
    const bool fused = (hi - lo) > 1;
    XcdBarrier bar; bar.bar = (unsigned*)(F.ctl + CW_BAR); bar.x = 0; bar.st = nullptr;
    if (fused) bar = xcd_barrier_post((unsigned*)(F.ctl + CW_BAR), F.MISC + 8);
#define IN(k) (lo <= (k) && (k) < hi)
#define SEAM(k) do { if (IN(k) && IN((k) + 1)) xcd_barrier(bar); } while (0)
    if (IN(0)) { p0a(F); SEAM(0); }
    if (IN(1)) { p0b(F); SEAM(1); }
    if (IN(2)) {
        pg8::Gemm g{(const bf16*)(F.ws + WS_H), (const bf16*)(F.ws + WS_WIN), T, INC, D / 2};
        pg8::StaticOrder So; So.init(T, INC, F.G, (int)blockIdx.x);
        { LAS float* lbl = (LAS float*)(F.lds + pg8::SCL_OFF + 4096); lbl[F.tid] = ((const float*)(F.ws + WS_MISC))[64 + F.tid]; __syncthreads(); }
        EpiProj E{(bf16*)(F.ws + WS_P), (float*)(F.ws + WS_HD), (const LAS float*)(F.lds + pg8::SCL_OFF + 4096), (const float*)(F.ws + WS_RS), (const float*)(F.ws + WS_CS)};
        pg8::gemm_phase<EpiProj, pg8::StaticOrder, true, true, true>(F.lds + RING_OFF, g, So, E);
        SEAM(2);
    }
    if (IN(3)) { hgrn::pass_a(F); SEAM(3); }
    if (IN(4)) { attn::attn_phase(F); hgrn::pass_c(F); SEAM(4); }
    if (IN(5)) {
        pg8::Gemm g{(const bf16*)(F.ws + WS_CAT), (const bf16*)(F.ws + WS_WOUT), T, D, D};
        pg8::StaticOrder So; So.init(T, D, F.G, (int)blockIdx.x);
        EpiBf16 E{(bf16*)(F.ws + WS_Y), D};
        pg8::gemm_phase<EpiBf16, pg8::StaticOrder, true, true>(F.lds + RING_OFF, g, So, E);
        SEAM(5);
    }
    if (IN(6)) { p_mid(F); SEAM(6); }
    if (IN(7)) {
        pg8::Gemm g{(const bf16*)(F.ws + WS_H8), (const bf16*)(F.ws + WS_WPQ), T, NPQ, D / 2};
        pg8::StaticOrder So; So.init(T, NPQ, F.G, (int)blockIdx.x);
        EpiBf16I8 E{(bf16*)(F.ws + WS_Q), NPQ, (const float*)(F.ws + WS_HS), (const float*)(F.ws + WS_CS2)};
        pg8::gemm_phase<EpiBf16I8, pg8::StaticOrder, true, true, true>(F.lds + RING_OFF, g, So, E);
        SEAM(7);
    }
    if (IN(8)) { topk::phase(F); SEAM(8); }
    if (IN(9)) { peer::phase(F); }
#undef IN
#undef SEAM
}
extern "C" void kernel_launch(void* const* d_in, const int* in_sizes, int n_in, void* d_out, int out_size, void* d_ws, size_t ws_size, hipStream_t stream) {
    static int grid = 0;
    if (grid == 0) {
        if (n_in != 18 || ws_size < WS_END) { fprintf(stderr, "kernel_launch: unexpected n_in %d / ws %zu\n", n_in, ws_size); grid = -1; return; }
        int dev = 0, cus = 0;
        if (hipGetDevice(&dev) != hipSuccess || hipDeviceGetAttribute(&cus, hipDeviceAttributeMultiprocessorCount, dev) != hipSuccess) { grid = -1; return; }
        if (hipFuncSetAttribute((const void*)mega, hipFuncAttributeMaxDynamicSharedMemorySize, LDS_BYTES) != hipSuccess) { fprintf(stderr, "hipFuncSetAttribute failed\n"); grid = -1; return; }
        grid = 256; (void)cus;
    }
    if (grid < 0) return;
    (void)hipMemsetAsync((char*)d_ws + WS_CTL, 0, CTL_ZERO_BYTES, stream);
    Args a{};
    for (int i = 0; i < 18; ++i) a.in[i] = (const float*)d_in[i];
    a.out = (float*)d_out; a.ws = (unsigned char*)d_ws;
    a.ph_lo = 0; a.ph_hi = 10;
    hipLaunchKernelGGL(mega, dim3(grid), dim3(NWAVES * 64), LDS_BYTES, stream, a);
}
```

```cpp
#include <hip/hip_runtime.h>
#include <cstdio>
#include <cstdint>

#define GAS __attribute__((address_space(1)))
#define LAS __attribute__((address_space(3)))
typedef unsigned short bf16;
typedef unsigned v4u __attribute__((ext_vector_type(4)));
typedef unsigned v2u __attribute__((ext_vector_type(2)));
typedef float f32x4 __attribute__((ext_vector_type(4)));
typedef float f32x16 __attribute__((ext_vector_type(16)));
typedef short bf16x8 __attribute__((ext_vector_type(8)));
typedef short s16x4 __attribute__((ext_vector_type(4)));
typedef GAS unsigned gu32;
#define RLX_AGENT __ATOMIC_RELAXED, __HIP_MEMORY_SCOPE_AGENT
#define LDS_WAIT() asm volatile("s_waitcnt lgkmcnt(0)" ::: "memory")
#define VM_WAIT() asm volatile("s_waitcnt vmcnt(0)" ::: "memory")

constexpr int D = 1024, NB = 8, S = 4096, T = NB * S;
constexpr int INC = 3584, NMOD = 6 * D, NEXP = 16384, NPQ = 2048;
constexpr float EPS = 1e-6f, LAM_INIT = 0.2f;
constexpr float LOG2E = 1.4426950408889634f;
constexpr float QSCALE = 0.125f * LOG2E;
constexpr int C_AQ = 0, C_AK = 512, C_AV = 1024, C_HQ = 1536, C_HF = 2048, C_HI = 2560, C_HG = 3072;
constexpr int NWAVES = 8;

constexpr size_t MiB = 1u << 20;
constexpr size_t WS_CTL = 0, CTL_ZERO_BYTES = 1 * MiB;
constexpr size_t WS_MOD = 1 * MiB;
constexpr size_t WS_MISC = 1 * MiB + 256 * 1024;
constexpr size_t WS_WIN = 2 * MiB, WS_WOUT = 9 * MiB, WS_WPQ = 11 * MiB, WS_KEYS = 15 * MiB;
constexpr size_t WS_HD = 16 * MiB;
constexpr size_t WS_EU8 = 17 * MiB, WS_EV8 = 33 * MiB;
constexpr size_t WS_SU = 49 * MiB, WS_SV = 49 * MiB + 512 * 1024;
constexpr size_t WS_H8 = 50 * MiB, WS_HS = 82 * MiB;
constexpr size_t WS_H = 96 * MiB;
constexpr size_t WS_P = 160 * MiB;
constexpr size_t PSTRIDE = (size_t)T * 512;
constexpr size_t WS_CAT = 384 * MiB;
constexpr size_t WS_Y = 160 * MiB;
constexpr size_t WS_Q = 224 * MiB;
constexpr size_t WS_PIDX = 352 * MiB, WS_PGATE = 368 * MiB;
constexpr size_t WS_LSC = 448 * MiB, WS_DSC = 464 * MiB;
constexpr size_t WS_Y2 = 224 * MiB;
constexpr size_t WS_RS = 83 * MiB;
constexpr size_t WS_CS2 = 512 * 1024 + 16384;
constexpr size_t WS_CS = 512 * 1024;
constexpr size_t WS_R1 = 82 * MiB + 256 * 1024;
constexpr size_t WS_X1 = 384 * MiB;
constexpr size_t WS_X1B = 96 * MiB;
constexpr size_t WS_END = 512 * MiB;
constexpr int CW_TMO = 0, CW_BAR = 4096;

__device__ __forceinline__ unsigned f2bf(float f) { unsigned u = __builtin_bit_cast(unsigned, f); return (u + 0x7fffu + ((u >> 16) & 1u)) >> 16; }
__device__ __forceinline__ unsigned pk2(float lo, float hi) { unsigned r; asm("v_cvt_pk_bf16_f32 %0, %1, %2" : "=v"(r) : "v"(lo), "v"(hi)); return r; }
__device__ __forceinline__ float bf2f(unsigned short h) { return __builtin_bit_cast(float, (unsigned)h << 16); }
__device__ __forceinline__ float bflo(unsigned w) { return __builtin_bit_cast(float, w << 16); }
__device__ __forceinline__ float bfhi(unsigned w) { return __builtin_bit_cast(float, w & 0xffff0000u); }
__device__ __forceinline__ float wave_sum(float v) {
#pragma unroll
    for (int o = 1; o < 64; o <<= 1) v += __shfl_xor(v, o);
    return v;
}
__device__ __forceinline__ float wave_sum_fast(float v) {
    v += __builtin_bit_cast(float, __builtin_amdgcn_update_dpp(0, __builtin_bit_cast(int, v), 0xB1, 0xf, 0xf, true));
    v += __builtin_bit_cast(float, __builtin_amdgcn_update_dpp(0, __builtin_bit_cast(int, v), 0x4E, 0xf, 0xf, true));
    v += __builtin_bit_cast(float, __builtin_amdgcn_update_dpp(0, __builtin_bit_cast(int, v), 0x141, 0xf, 0xf, true));
    v += __builtin_bit_cast(float, __builtin_amdgcn_update_dpp(0, __builtin_bit_cast(int, v), 0x140, 0xf, 0xf, true));
    const int i = __builtin_bit_cast(int, v);
    return (__builtin_bit_cast(float, __builtin_amdgcn_readlane(i, 0)) + __builtin_bit_cast(float, __builtin_amdgcn_readlane(i, 16))) +
           (__builtin_bit_cast(float, __builtin_amdgcn_readlane(i, 32)) + __builtin_bit_cast(float, __builtin_amdgcn_readlane(i, 48)));
}
__device__ __forceinline__ float wave_max_fast(float v) {
    v = fmaxf(v, __builtin_bit_cast(float, __builtin_amdgcn_update_dpp(0, __builtin_bit_cast(int, v), 0xB1, 0xf, 0xf, true)));
    v = fmaxf(v, __builtin_bit_cast(float, __builtin_amdgcn_update_dpp(0, __builtin_bit_cast(int, v), 0x4E, 0xf, 0xf, true)));
    v = fmaxf(v, __builtin_bit_cast(float, __builtin_amdgcn_update_dpp(0, __builtin_bit_cast(int, v), 0x141, 0xf, 0xf, true)));
    v = fmaxf(v, __builtin_bit_cast(float, __builtin_amdgcn_update_dpp(0, __builtin_bit_cast(int, v), 0x140, 0xf, 0xf, true)));
    const int i = __builtin_bit_cast(int, v);
    return fmaxf(fmaxf(__builtin_bit_cast(float, __builtin_amdgcn_readlane(i, 0)), __builtin_bit_cast(float, __builtin_amdgcn_readlane(i, 16))),
                 fmaxf(__builtin_bit_cast(float, __builtin_amdgcn_readlane(i, 32)), __builtin_bit_cast(float, __builtin_amdgcn_readlane(i, 48))));
}
__device__ __forceinline__ float siluf(float x) { return x * __builtin_amdgcn_rcpf(1.f + __expf(-x)); }
__device__ __forceinline__ float sigmf(float x) { return __builtin_amdgcn_rcpf(1.f + __expf(-x)); }
template <int CTRL> __device__ __forceinline__ float dpp_one(float v) { return __builtin_bit_cast(float, __builtin_amdgcn_update_dpp(0x3f800000, __builtin_bit_cast(int, v), CTRL, 0xf, 0xf, false)); }
typedef float f32x2 __attribute__((ext_vector_type(2)));
template <int CTRL> __device__ __forceinline__ float dpp_f(float v) { return __builtin_bit_cast(float, __builtin_amdgcn_update_dpp(0, __builtin_bit_cast(int, v), CTRL, 0xf, 0xf, true)); }

__device__ __forceinline__ void glds16(const void* gsrc, unsigned lds_dst) { unsigned keep;
    asm volatile("s_mov_b32 %0, m0\n\ts_mov_b32 m0, %2\n\ts_nop 0\n\tglobal_load_lds_dwordx4 %1, off\n\ts_mov_b32 m0, %0" : "=&s"(keep) : "v"(gsrc), "s"(lds_dst) : "memory"); }
__device__ __forceinline__ unsigned lds_addr(LAS const void* p) { return (unsigned)__builtin_amdgcn_readfirstlane((int)(unsigned)(size_t)p); }
#define XB_TMO      128
#define XB_XCNT(j)  (256  + 64 * (j))
#define XB_XSUB(j)  (1280 + 64 * (j))
#define XB_XGEN(j)  (2304 + 64 * (j))
#define XB_TOP      3328
#define XB_TOPGEN   3392
#define XCD_BAR_WORDS 3456
#define XB_SPIN_CAP (1u << 18)
__device__ __forceinline__ unsigned xb_ld(unsigned* p)              { return __hip_atomic_load(p, __ATOMIC_RELAXED, __HIP_MEMORY_SCOPE_AGENT); }
__device__ __forceinline__ unsigned xb_add(unsigned* p, unsigned v) { return __hip_atomic_fetch_add(p, v, __ATOMIC_RELAXED, __HIP_MEMORY_SCOPE_AGENT); }
__device__ __forceinline__ unsigned xb_xcc_id() { return (unsigned)__builtin_amdgcn_s_getreg((3 << 11) | 20) & 0xFu; }
#define XB_SPIN(cond, bar) do { unsigned _sp = 0; while (cond) { __builtin_amdgcn_s_sleep(1); \
    if ((++_sp & 255u) == 0u) { if (xb_ld(&(bar)[XB_TMO])) break; if (_sp > XB_SPIN_CAP) { atomicAdd(&(bar)[XB_TMO], 1u); break; } } } } while (0)
struct XcdBarrier { unsigned* bar; unsigned x; volatile LAS unsigned* st; };
__device__ __forceinline__ XcdBarrier xcd_barrier_post(unsigned* bar, volatile LAS unsigned* st) {
    XcdBarrier b; b.bar = bar; b.x = xb_xcc_id(); b.st = st;
    if (threadIdx.x == 0) (void)xb_add(&bar[XB_XCNT(b.x)], 1u);
    return b;
}
__device__ __forceinline__ void xcd_barrier_complete(unsigned* bar, unsigned x, unsigned& nloc, unsigned& nx) {
    const unsigned G = gridDim.x * gridDim.y * gridDim.z;
    unsigned sum, cnt, mine, sp = 0u;
    for (;;) {
        sum = 0u; cnt = 0u; mine = 0u;
#pragma unroll
        for (unsigned j = 0; j < 16; ++j) { const unsigned c = xb_ld(&bar[XB_XCNT(j)]); sum += c; cnt += (c > 0u) ? 1u : 0u; mine = (j == x) ? c : mine; }
        if (sum == G) break;
        __builtin_amdgcn_s_sleep(1);
        if ((++sp & 255u) == 0u) { if (xb_ld(&bar[XB_TMO])) break; if (sp > XB_SPIN_CAP) { atomicAdd(&bar[XB_TMO], 1u); break; } }
    }
    nloc = mine > 0u ? mine : 1u; nx = cnt > 0u ? cnt : 1u;
}
__device__ __forceinline__ void xcd_barrier(const XcdBarrier& b) {
    asm volatile("s_waitcnt vmcnt(0)" ::: "memory");
    __syncthreads();
    if (threadIdx.x == 0) {
        unsigned* bar = b.bar;
        __builtin_amdgcn_s_waitcnt(0);
        unsigned nloc = b.st[0], nx = b.st[1];
        if (nloc == 0u) { xcd_barrier_complete(bar, b.x, nloc, nx); b.st[0] = nloc; b.st[1] = nx; }
        const unsigned old = xb_add(&bar[XB_XSUB(b.x)], 1u);
        const unsigned gen = old / nloc;
        if (old + 1u == (gen + 1u) * nloc) {
            __builtin_amdgcn_fence(__ATOMIC_RELEASE, "agent");
            asm volatile("s_waitcnt vmcnt(0)" ::: "memory");
            const unsigned og = xb_add(&bar[XB_TOP], 1u);
            const unsigned tg = og / nx;
            if (og + 1u == (tg + 1u) * nx) xb_add(&bar[XB_TOPGEN], 1u);
            else XB_SPIN(xb_ld(&bar[XB_TOPGEN]) == tg, bar);
            __builtin_amdgcn_fence(__ATOMIC_ACQUIRE, "agent");
            xb_add(&bar[XB_XGEN(b.x)], 1u);
            asm volatile("s_waitcnt vmcnt(0)" ::: "memory");
        } else {
            XB_SPIN(xb_ld(&bar[XB_XGEN(b.x)]) == gen, bar);
            __builtin_amdgcn_fence(__ATOMIC_ACQUIRE, "agent");
            asm volatile("s_waitcnt vmcnt(0)" ::: "memory");
        }
    }
    __syncthreads();
}
namespace pg8 {
#define PG8_LAS __attribute__((address_space(3)))
typedef unsigned short bf16_t;
typedef short bf16x8 __attribute__((ext_vector_type(8)));
typedef float f32x4 __attribute__((ext_vector_type(4)));
typedef unsigned u32x4 __attribute__((ext_vector_type(4)));
constexpr int SCL_OFF = 131072 + 8192;
constexpr int BM = 256, BK = 64, HALF = 128, HTB = HALF * BK * 2, STAGE_BYTES = 8 * HTB, NXCD = 8, WGM = 4;

__host__ __device__ __forceinline__ int lds_byte(int r, int c) { const int st = (r >> 4) * 2 + (c >> 5), rr = r & 15, cc = c & 31, ob = rr * 64 + cc * 2; return st * 1024 + (ob ^ (((ob >> 9) & 1) << 5)); }
__host__ __device__ __forceinline__ void stage_rc(int b, int& R, int& C) { const int st = b / 1024, sb = b % 1024, swz = sb ^ (((sb >> 9) & 1) << 5); R = (st >> 1) * 16 + swz / 64; C = (st & 1) * 32 + (swz % 64) / 2; }
__host__ __device__ __forceinline__ int perm32(int rho) { const int n = rho >> 4, i = rho & 15; return 8 * (i >> 2) + 4 * n + (i & 3); }

struct Unit { int pm, pn; };
struct Gemm { const bf16_t* A; const bf16_t* Bt; int M, N, K; };

struct StaticOrder {
    int nM, nN, nwg, G, c;
    __host__ __device__ void init(int M, int N, int G_, int c_) { nM = M / BM; nN = N / BM; nwg = nM * nN; G = G_; c = c_; }
    __host__ __device__ bool next(int i, Unit& u) const {
        const long L = (long)i * G + c; if (L >= nwg) return false;
        int wgid = (int)L; { const int q = nwg / NXCD, r = nwg % NXCD, xcd = wgid % NXCD, off = wgid / NXCD; wgid = (xcd < r ? xcd * (q + 1) : r * (q + 1) + (xcd - r) * q) + off; }
        const int nig = WGM * nN, gid = wgid / nig, fm = gid * WGM, gsz = (nM - fm) < WGM ? (nM - fm) : WGM;
        u.pm = fm + ((wgid % nig) % gsz); u.pn = (wgid % nig) / gsz; return true;
    }
    __device__ __forceinline__ void a_ready(const Unit&) const {}
    __device__ __forceinline__ void done(const Unit&) const {}
};

__device__ __forceinline__ unsigned cvt_pk_bf16(float lo, float hi) { unsigned r; asm volatile("v_cvt_pk_bf16_f32 %0, %1, %2" : "=v"(r) : "v"(lo), "v"(hi)); return r; }

typedef int i32x4 __attribute__((ext_vector_type(4)));
template <class Epi, class Sched, bool ALIGN_EPI = false, bool SP2 = false, bool I8 = false>
__device__ __forceinline__ void gemm_phase(PG8_LAS unsigned char* lds, const Gemm g, const Sched& S, const Epi& E) {
    const int tid = threadIdx.x, wid = __builtin_amdgcn_readfirstlane(tid >> 6), lane = tid & 63, wr = wid >> 2, wc = wid & 3, fr = lane & 15, fq = lane >> 4;
    const int K = g.K, nt = K / BK;
    unsigned voffA[2], voffB[2];
#pragma unroll
    for (int i = 0; i < 2; ++i) { int R, C; stage_rc(tid * 16 + i * 8192, R, C); const int Rb = Epi::PERM ? ((R & ~31) + perm32(R & 31)) : R;
        voffA[i] = (unsigned)(R * K + C) * 2u; voffB[i] = (unsigned)(Rb * K + C) * 2u; }
    const size_t kstep = (size_t)(BK * 2);
    const size_t hstep = (size_t)HALF * K * 2;
    const size_t tstep = 2 * hstep;
    const unsigned ldsw = (unsigned)wid * 1024u;
    const int aoff = lds_byte(wr * 64 + fr, fq * 8), boff = lds_byte(wc * 32 + fr, fq * 8);
#define PG8_SA(b, h) (((b) * 2 + (h)) * HTB)
#define PG8_SB(b, h) ((4 + (b) * 2 + (h)) * HTB)
#define PG8_STAGE(bufoff, gbase, voff) do { _Pragma("unroll") for (int _i = 0; _i < 2; ++_i) \
        __builtin_amdgcn_global_load_lds((const unsigned*)((const char*)(gbase) + (voff)[_i]), (PG8_LAS unsigned*)(lds + (bufoff) + ldsw + _i * 8192), 16, 0, 0); } while (0)
#define PG8_LDA(dst, b, h) do { _Pragma("unroll") for (int m = 0; m < 4; ++m) _Pragma("unroll") for (int k = 0; k < 2; ++k) dst[m][k] = *(const PG8_LAS bf16x8*)(lds + PG8_SA(b, h) + aoff + m * 2048 + k * 1024); } while (0)
#define PG8_LDB(dst, b, h) do { _Pragma("unroll") for (int n = 0; n < 2; ++n) _Pragma("unroll") for (int k = 0; k < 2; ++k) dst[n][k] = *(const PG8_LAS bf16x8*)(lds + PG8_SB(b, h) + boff + n * 2048 + k * 1024); } while (0)
#define PG8_MMA(ai, bj, At, Bt) do { __builtin_amdgcn_s_setprio(1); _Pragma("unroll") for (int m = 0; m < 4; ++m) _Pragma("unroll") for (int n = 0; n < 2; ++n) _Pragma("unroll") for (int k = 0; k < 2; ++k) \
        { if constexpr (I8) acc[ai][bj][m][n] = __builtin_bit_cast(f32x4, __builtin_amdgcn_mfma_i32_16x16x64_i8(__builtin_bit_cast(i32x4, Bt[n][k]), __builtin_bit_cast(i32x4, At[m][k]), __builtin_bit_cast(i32x4, acc[ai][bj][m][n]), 0, 0, 0)); \
          else acc[ai][bj][m][n] = __builtin_amdgcn_mfma_f32_16x16x32_bf16(Bt[n][k], At[m][k], acc[ai][bj][m][n], 0, 0, 0); } __builtin_amdgcn_s_setprio(0); } while (0)
#define PG8_WAIT_V(n) asm volatile("s_waitcnt vmcnt(" #n ")" ::: "memory")
#define PG8_WAIT_L(n) asm volatile("s_waitcnt lgkmcnt(" #n ")" ::: "memory")
#define PG8_BAR __builtin_amdgcn_s_barrier()
#define PG8_SCHED __builtin_amdgcn_sched_barrier(0)
    Unit cur, nxt; int ui = 0;
    if (!S.next(0, cur)) return;
    f32x4 acc[2][2][4][2];
#pragma unroll
    for (int a = 0; a < 2; ++a)
#pragma unroll
        for (int b = 0; b < 2; ++b)
#pragma unroll
            for (int m = 0; m < 4; ++m)
#pragma unroll
                for (int n = 0; n < 2; ++n) acc[a][b][m][n] = (f32x4){0.f, 0.f, 0.f, 0.f};
    bf16x8 At[4][2], B0[2][2], B1[2][2];
    const char* cA = (const char*)g.A + (size_t)cur.pm * tstep; const char* cB = (const char*)g.Bt + (size_t)cur.pn * tstep;
    S.a_ready(cur);
    if constexpr (SP2) {
        PG8_STAGE(PG8_SB(0, 0), cB, voffB); PG8_STAGE(PG8_SB(0, 1), cB + hstep, voffB); PG8_STAGE(PG8_SA(0, 0), cA, voffA); PG8_STAGE(PG8_SA(0, 1), cA + hstep, voffA);
        if (wr == 1) PG8_BAR;
        PG8_WAIT_V(2); PG8_BAR;
        PG8_STAGE(PG8_SB(1, 0), cB + kstep, voffB); PG8_STAGE(PG8_SA(1, 0), cA + kstep, voffA); PG8_STAGE(PG8_SB(1, 1), cB + hstep + kstep, voffB);
        PG8_WAIT_V(6); PG8_BAR;
    } else {
        PG8_STAGE(PG8_SB(0, 0), cB, voffB); PG8_STAGE(PG8_SA(0, 0), cA, voffA); PG8_STAGE(PG8_SB(0, 1), cB + hstep, voffB); PG8_STAGE(PG8_SA(0, 1), cA + hstep, voffA);
        if (wr == 1) PG8_BAR;
        PG8_WAIT_V(4); PG8_BAR;
        PG8_STAGE(PG8_SB(1, 0), cB + kstep, voffB); PG8_STAGE(PG8_SA(1, 0), cA + kstep, voffA); PG8_STAGE(PG8_SB(1, 1), cB + hstep + kstep, voffB);
        PG8_WAIT_V(6); PG8_BAR;
    }
    if constexpr (Epi::LDS_SCALE) __builtin_amdgcn_global_load_lds((const unsigned*)(E.scale_base(cur, wid) + lane), (PG8_LAS unsigned*)(lds + SCL_OFF + wid * 256), 4, 0, 0);
    for (;;) {
        const bool has_next = S.next(ui + 1, nxt);
        const char* nA = has_next ? (const char*)g.A + (size_t)nxt.pm * tstep : cA; const char* nB = has_next ? (const char*)g.Bt + (size_t)nxt.pn * tstep : cB;
        for (int t = 0; t < nt; t += 2) {
            const bool last = (t == nt - 2);
            const char* a1 = cA + (size_t)(t + 1) * kstep;
            const char* a2 = last ? nA : cA + (size_t)(t + 2) * kstep; const char* b2 = last ? nB : cB + (size_t)(t + 2) * kstep;
            const char* a3 = a2 + kstep; const char* b3 = b2 + kstep;
            if (last && has_next) S.a_ready(nxt);
            if constexpr (SP2) {
            PG8_LDB(B0, 0, 0); PG8_LDB(B1, 0, 1); PG8_SCHED; PG8_LDA(At, 0, 0); PG8_STAGE(PG8_SA(1, 1), a1 + hstep, voffA);
            PG8_WAIT_V(8); PG8_WAIT_L(0); PG8_BAR;
            PG8_MMA(0, 0, At, B0); PG8_MMA(0, 1, At, B1); PG8_BAR; PG8_SCHED;
            PG8_LDA(At, 0, 1); PG8_STAGE(PG8_SB(0, 0), b2, voffB); PG8_STAGE(PG8_SB(0, 1), b2 + hstep, voffB); PG8_STAGE(PG8_SA(0, 0), a2, voffA);
            PG8_WAIT_V(8); PG8_WAIT_L(0); PG8_BAR; PG8_MMA(1, 0, At, B0); PG8_MMA(1, 1, At, B1); PG8_BAR; PG8_SCHED;
            PG8_LDB(B0, 1, 0); PG8_LDB(B1, 1, 1); PG8_SCHED; PG8_LDA(At, 1, 0); PG8_STAGE(PG8_SA(0, 1), a2 + hstep, voffA);
            PG8_WAIT_V(8); PG8_WAIT_L(0); PG8_BAR; PG8_MMA(0, 0, At, B0); PG8_MMA(0, 1, At, B1); PG8_BAR; PG8_SCHED;
            PG8_LDA(At, 1, 1); PG8_STAGE(PG8_SB(1, 0), b3, voffB); PG8_STAGE(PG8_SB(1, 1), b3 + hstep, voffB); PG8_STAGE(PG8_SA(1, 0), a3, voffA);
            PG8_WAIT_V(8); PG8_WAIT_L(0); PG8_BAR; PG8_MMA(1, 0, At, B0); PG8_MMA(1, 1, At, B1); PG8_BAR; PG8_SCHED;
            } else {
            PG8_LDB(B0, 0, 0); PG8_SCHED; PG8_LDA(At, 0, 0); PG8_STAGE(PG8_SA(1, 1), a1 + hstep, voffA);
            PG8_WAIT_L(8); PG8_BAR; PG8_WAIT_L(0); PG8_MMA(0, 0, At, B0); PG8_BAR; PG8_SCHED;
            PG8_LDB(B1, 0, 1); PG8_STAGE(PG8_SB(0, 0), b2, voffB);
            PG8_BAR; PG8_WAIT_L(0); PG8_MMA(0, 1, At, B1); PG8_BAR;
            PG8_LDA(At, 0, 1); PG8_STAGE(PG8_SA(0, 0), a2, voffA);
            PG8_BAR; PG8_WAIT_L(0); PG8_MMA(1, 0, At, B0); PG8_BAR; PG8_SCHED;
            PG8_STAGE(PG8_SB(0, 1), b2 + hstep, voffB);
            PG8_WAIT_V(6); PG8_BAR; PG8_MMA(1, 1, At, B1); PG8_BAR;
            PG8_LDB(B0, 1, 0); PG8_SCHED; PG8_LDA(At, 1, 0); PG8_STAGE(PG8_SA(0, 1), a2 + hstep, voffA);
            PG8_WAIT_L(8); PG8_BAR; PG8_WAIT_L(0); PG8_MMA(0, 0, At, B0); PG8_BAR; PG8_SCHED;
            PG8_LDB(B1, 1, 1); PG8_STAGE(PG8_SB(1, 0), b3, voffB);
            PG8_BAR; PG8_WAIT_L(0); PG8_MMA(0, 1, At, B1); PG8_BAR;
            PG8_LDA(At, 1, 1); PG8_STAGE(PG8_SA(1, 0), a3, voffA);
            PG8_BAR; PG8_WAIT_L(0); PG8_MMA(1, 0, At, B0); PG8_BAR; PG8_SCHED;
            PG8_STAGE(PG8_SB(1, 1), b3 + hstep, voffB);
            PG8_WAIT_V(6); PG8_BAR; PG8_MMA(1, 1, At, B1); PG8_BAR;
            }
        }
        if constexpr (Epi::LDS_SCALE) { if (has_next) __builtin_amdgcn_global_load_lds((const unsigned*)(E.scale_base(nxt, wid) + lane), (PG8_LAS unsigned*)(lds + SCL_OFF + ((ui + 1) & 1) * 2048 + wid * 256), 4, 0, 0); }
        if constexpr (ALIGN_EPI) { if (wr == 0) PG8_BAR; }
        if constexpr (!Epi::AFTER_DRAIN) { if constexpr (Epi::LDS_SCALE) E(acc, cur, wr, wc, fr, fq, (const PG8_LAS float*)(lds + SCL_OFF + (ui & 1) * 2048)); else E(acc, cur, wr, wc, fr, fq); S.done(cur); }
        if (!has_next) break;
#pragma unroll
        for (int a = 0; a < 2; ++a)
#pragma unroll
            for (int b = 0; b < 2; ++b)
#pragma unroll
                for (int m = 0; m < 4; ++m)
#pragma unroll
                    for (int n = 0; n < 2; ++n) acc[a][b][m][n] = (f32x4){0.f, 0.f, 0.f, 0.f};
        cur = nxt; cA = nA; cB = nB; ++ui;
        if constexpr (ALIGN_EPI) { if (wr == 1) PG8_BAR; }
    }
    PG8_WAIT_V(0);
    if constexpr (!ALIGN_EPI) { if (wr == 0) PG8_BAR; }
    PG8_BAR;
    if constexpr (Epi::AFTER_DRAIN) { E.fused(acc, cur, wr, wc, fr, fq, lds, wid, lane); S.done(cur); }
#undef PG8_SA
#undef PG8_SB
#undef PG8_STAGE
#undef PG8_LDA
#undef PG8_LDB
#undef PG8_MMA
#undef PG8_WAIT_V
#undef PG8_WAIT_L
#undef PG8_BAR
#undef PG8_SCHED
}
}
constexpr int RING_OFF = 0, RING_BYTES = 131072;
constexpr int LDSCTL_OFF = RING_BYTES, MISC_OFF = LDSCTL_OFF + 320;
constexpr int LDS_BYTES = 163840;
constexpr int HDS_OFF = 139264;
constexpr int TOPK_TAB_OFF = 139264;

struct Frame {
    LAS unsigned char* lds;
    volatile LAS unsigned* MISC;
    gu32* ctl;
    int tid, lane, wave, vcu, G;
    const float* const* in;
    float* out; unsigned char* ws;
};
enum { I_X = 0, I_C, I_WADA, I_BADA, I_GPRE1, I_GPOST1, I_GPRE2, I_GPOST2, I_WIN, I_LAMQK, I_GSUB, I_LBTH, I_GHOUT, I_WOUT, I_WPQ, I_KEYS, I_EU, I_EV };

__device__ __forceinline__ void p0_transpose_item(const float* W, int K, int N, int src_col0, bf16* WT, int dst_row0, LAS float* scr, int kb, int lane) {
    const int k0 = 64 * kb;
#pragma unroll
    for (int i = 0; i < 32; ++i) { const int kk = 2 * i + (lane >> 5); scr[kk * 33 + (lane & 31)] = W[(size_t)(k0 + kk) * N + src_col0 + (lane & 31)]; }
    LDS_WAIT(); asm volatile("" ::: "memory");
    const int c = lane & 7;
#pragma unroll
    for (int j = 0; j < 4; ++j) { const int n = (lane >> 3) + 8 * j; const LAS float* s = scr + (8 * c) * 33 + n;
        v4u o; o.x = pk2(s[0 * 33], s[1 * 33]); o.y = pk2(s[2 * 33], s[3 * 33]); o.z = pk2(s[4 * 33], s[5 * 33]); o.w = pk2(s[6 * 33], s[7 * 33]);
        *(GAS v4u*)(WT + (size_t)(dst_row0 + n) * K + k0 + 8 * c) = o; }
    LDS_WAIT(); asm volatile("" ::: "memory");
}
__device__ __forceinline__ int win_src_col(int n) {
    if (n < C_HQ || n >= C_HI) return n;
    const int h = (n - C_HQ) >> 8, c = (n - C_HQ) & 255;
    return c < 128 ? C_HQ + 128 * h + c : C_HF + 128 * h + (c - 128);
}
__device__ __forceinline__ void cvt_plain(const float* src, bf16* dst, size_t ngroups, size_t g0, size_t gstride) {
    for (size_t gi = g0; gi < ngroups; gi += gstride) {
        const f32x4 a = *(const GAS f32x4*)(src + gi * 8), b = *(const GAS f32x4*)(src + gi * 8 + 4);
        v4u o; o.x = pk2(a.x, a.y); o.y = pk2(a.z, a.w); o.z = pk2(b.x, b.y); o.w = pk2(b.z, b.w);
        *(GAS v4u*)(dst + gi * 8) = o;
    }
}
__device__ __forceinline__ void tab_load(const Frame& F, int r, f32x4 (&v)[4]) {
    const bool isv = r >= NEXP; const int e = isv ? r - NEXP : r;
    const GAS f32x4* src = (const GAS f32x4*)((isv ? F.in[I_EV] : F.in[I_EU]) + (size_t)e * D) + F.lane;
#pragma unroll
    for (int j = 0; j < 4; ++j) v[j] = __builtin_nontemporal_load(src + 64 * j);
}
__device__ __forceinline__ void tab_finish(const Frame& F, int r, const f32x4 (&v)[4]) {
    const bool isv = r >= NEXP; const int e = isv ? r - NEXP : r; float am = 0.f;
#pragma unroll
    for (int j = 0; j < 4; ++j) am = fmaxf(am, fmaxf(fmaxf(fabsf(v[j].x), fabsf(v[j].y)), fmaxf(fabsf(v[j].z), fabsf(v[j].w))));
    am = fmaxf(wave_max_fast(am), 1e-30f);
    const float inv = 127.f / am;
    GAS unsigned* dst = (GAS unsigned*)(F.ws + (isv ? WS_EV8 : WS_EU8) + (size_t)e * D) + F.lane;
#pragma unroll
    for (int j = 0; j < 4; ++j) {
        const int q0 = (int)rintf(v[j].x * inv), q1 = (int)rintf(v[j].y * inv), q2 = (int)rintf(v[j].z * inv), q3 = (int)rintf(v[j].w * inv);
        dst[64 * j] = (unsigned)(q0 & 255) | ((unsigned)(q1 & 255) << 8) | ((unsigned)(q2 & 255) << 16) | ((unsigned)(q3 & 255) << 24);
    }
    if (F.lane == 0) ((float*)(F.ws + WS_SU))[2 * e + (isv ? 1 : 0)] = am * (1.f / 127.f);
}
__device__ __forceinline__ void p0a(Frame& F) {
    LAS float* scr = (LAS float*)(F.lds + RING_OFF + F.wave * 16384);
    const int gw = F.vcu * NWAVES + F.wave, NGW = F.G * NWAVES;
    bf16* WIN = (bf16*)(F.ws + WS_WIN); bf16* WOUT = (bf16*)(F.ws + WS_WOUT); bf16* WPQ = (bf16*)(F.ws + WS_WPQ);
    constexpr int I1 = 16 * (INC / 32), I2 = 16 * (D / 32), I3 = 16 * (NPQ / 32);
    f32x4 wv[16];
    { const int n0e = (F.vcu < NMOD / 32 ? F.vcu : 0) * 32, cq = F.lane & 7, kk = F.lane >> 3;
#pragma unroll
      for (int i = 0; i < 16; ++i) wv[i] = __builtin_nontemporal_load((const GAS f32x4*)(F.in[I_WADA] + (size_t)(128 * F.wave + 8 * i + kk) * NMOD + n0e + 4 * cq)); }
    for (int it = gw; it < I1 + I2 + I3; it += NGW) {
        int r = it;
        if (r < I1) {
            const int kb = r / (INC / 32), nb = r % (INC / 32); const float* W = F.in[I_WIN]; const int sc = win_src_col(nb * 32) + (F.lane & 31); float am = 0.f;
#pragma unroll
            for (int i = 0; i < 32; ++i) am = fmaxf(am, fabsf(W[(size_t)(64 * kb + 2 * i + (F.lane >> 5)) * INC + sc]));
            am = fmaxf(am, __shfl_xor(am, 32));
            if (F.lane < 32) atomicMax((int*)(F.ws + WS_CS) + nb * 32 + F.lane, __builtin_bit_cast(int, am));
            continue; } r -= I1;
        if (r < I2) { const int kb = r / (D / 32), nb = r % (D / 32); p0_transpose_item(F.in[I_WOUT], D, D, nb * 32, WOUT, nb * 32, scr, kb, F.lane); continue; } r -= I2;
        { const int kb = r / (NPQ / 32), nb = r % (NPQ / 32); const float* W = F.in[I_WPQ]; const int sc = nb * 32 + (F.lane & 31); float am = 0.f;
#pragma unroll
          for (int i = 0; i < 32; ++i) am = fmaxf(am, fabsf(W[(size_t)(64 * kb + 2 * i + (F.lane >> 5)) * NPQ + sc]));
          am = fmaxf(am, __shfl_xor(am, 32));
          if (F.lane < 32) atomicMax((int*)(F.ws + WS_CS2) + nb * 32 + F.lane, __builtin_bit_cast(int, am)); }
    }
    const size_t g0 = (size_t)gw * 64 + F.lane, gs = (size_t)NGW * 64;
    cvt_plain(F.in[I_KEYS], (bf16*)(F.ws + WS_KEYS), (size_t)16 * 128 * 128 / 8, g0, gs);
    __syncthreads();
    if (F.vcu < NMOD / 32) { LAS float* cs = (LAS float*)(F.lds + RING_OFF + 32768); const float* cc = F.in[I_C];
        for (int i = F.tid; i < NB * D; i += NWAVES * 64) cs[i] = siluf(cc[i]);
        __syncthreads(); }
    for (int item = F.vcu; item < NMOD / 32; item += F.G) {
        const int n0 = item * 32, cq = F.lane & 7, kk = F.lane >> 3;
        const float* wa = F.in[I_WADA]; LAS const float* cs = (LAS const float*)(F.lds + RING_OFF + 32768);
        f32x4 acc[NB];
#pragma unroll
        for (int b = 0; b < NB; ++b) acc[b] = (f32x4){0.f, 0.f, 0.f, 0.f};
#pragma unroll
        for (int i = 0; i < 16; ++i) { const int k = 128 * F.wave + 8 * i + kk;
#pragma unroll
            for (int b = 0; b < NB; ++b) acc[b] += wv[i] * cs[b * D + k]; }
        LAS float* red = (LAS float*)(F.lds + RING_OFF + 65536);
#pragma unroll
        for (int b = 0; b < NB; ++b) *(LAS f32x4*)(red + ((F.wave * 8 + kk) * 8 + b) * 32 + 4 * cq) = acc[b];
        __syncthreads();
        if (F.tid < 256) { float s = 0.f;
#pragma unroll 16
            for (int p = 0; p < 64; ++p) s += red[p * 256 + F.tid];
            ((float*)(F.ws + WS_MOD))[(F.tid >> 5) * NMOD + n0 + (F.tid & 31)] = s + F.in[I_BADA][n0 + (F.tid & 31)]; }
        __syncthreads();
    }
    if (F.vcu == F.G - 1 && F.wave == 0) {
        float* misc = (float*)(F.ws + WS_MISC); const float* lq = F.in[I_LAMQK]; const float* lt = F.in[I_LBTH]; const int l = F.lane;
        const float a = wave_sum(lq[l] * lq[64 + l]), b = wave_sum(lq[128 + l] * lq[192 + l]);
        if (l == 0) misc[0] = __expf(a) - __expf(b) + LAM_INIT;
        for (int i = l; i < 512; i += 64) misc[64 + i] = 1.f / (1.f + __expf(lt[512 + i] - lt[i]));
    }
}
__device__ __forceinline__ void p0_qtranspose_item(const float* W, int K, int N, int src_col0, signed char* WT, int dst_row0, const float* amax, LAS float* scr, int kb, int lane) {
    const int k0 = 64 * kb;
#pragma unroll
    for (int i = 0; i < 32; ++i) { const int kk = 2 * i + (lane >> 5); scr[kk * 33 + (lane & 31)] = W[(size_t)(k0 + kk) * N + src_col0 + (lane & 31)]; }
    LDS_WAIT(); asm volatile("" ::: "memory");
    const int c = lane & 7;
#pragma unroll
    for (int j = 0; j < 4; ++j) { const int n = (lane >> 3) + 8 * j; const LAS float* s = scr + (8 * c) * 33 + n;
        const float inv = 127.f / fmaxf(amax[dst_row0 + n], 1e-30f);
        int q[8];
#pragma unroll
        for (int e = 0; e < 8; ++e) q[e] = (int)rintf(s[e * 33] * inv) & 255;
        v2u o; o.x = (unsigned)q[0] | ((unsigned)q[1] << 8) | ((unsigned)q[2] << 16) | ((unsigned)q[3] << 24); o.y = (unsigned)q[4] | ((unsigned)q[5] << 8) | ((unsigned)q[6] << 16) | ((unsigned)q[7] << 24);
        *(GAS v2u*)(WT + (size_t)(dst_row0 + n) * K + k0 + 8 * c) = o; }
    LDS_WAIT(); asm volatile("" ::: "memory");
}
__device__ __forceinline__ void p0b(Frame& F) {
    const int gw = F.vcu * NWAVES + F.wave, NGW = F.G * NWAVES;
    { LAS float* scr = (LAS float*)(F.lds + RING_OFF + F.wave * 16384);
      for (int it = gw; it < 16 * (INC / 32); it += NGW) { const int kb = it / (INC / 32), nb = it % (INC / 32);
          p0_qtranspose_item(F.in[I_WIN], D, INC, win_src_col(nb * 32), (signed char*)(F.ws + WS_WIN), nb * 32, (const float*)(F.ws + WS_CS), scr, kb, F.lane); }
      for (int it = gw; it < 16 * (NPQ / 32); it += NGW) { const int kb = it / (NPQ / 32), nb = it % (NPQ / 32);
          p0_qtranspose_item(F.in[I_WPQ], D, NPQ, nb * 32, (signed char*)(F.ws + WS_WPQ), nb * 32, (const float*)(F.ws + WS_CS2), scr, kb, F.lane); } }
    const float* x = F.in[I_X]; const float* g = F.in[I_GPRE1]; const float* mod = (const float*)(F.ws + WS_MOD);
    f32x4 pg[4], psc[4], psh[4];
    { const int b = (16 * gw) / S;
#pragma unroll
      for (int j = 0; j < 4; ++j) { const int col = (F.lane + 64 * j) * 4; pg[j] = *(const f32x4*)(g + col); psc[j] = 1.f + *(const f32x4*)(mod + b * NMOD + D + col); psh[j] = *(const f32x4*)(mod + b * NMOD + col); } }
#pragma unroll 1
    for (int m0 = 16 * gw; m0 < 16 * gw + 16; m0 += 4) {
        f32x4 v[4][4];
#pragma unroll
        for (int q = 0; q < 4; ++q) { const GAS f32x4* xr = (const GAS f32x4*)(x + (size_t)(m0 + q) * D) + F.lane;
#pragma unroll
            for (int j = 0; j < 4; ++j) v[q][j] = __builtin_nontemporal_load(xr + 64 * j); }
#pragma unroll
        for (int q = 0; q < 4; ++q) {
            const int m = m0 + q; float ss = 0.f;
#pragma unroll
            for (int j = 0; j < 4; ++j) ss += (v[q][j].x * v[q][j].x + v[q][j].y * v[q][j].y) + (v[q][j].z * v[q][j].z + v[q][j].w * v[q][j].w);
            const float r = rsqrtf(wave_sum_fast(ss) * (1.f / D) + EPS);
            float am = 0.f;
#pragma unroll
            for (int j = 0; j < 4; ++j) {
                const f32x4 y = v[q][j] * r * pg[j] * psc[j] + psh[j]; v[q][j] = y;
                am = fmaxf(am, fmaxf(fmaxf(fabsf(y.x), fabsf(y.y)), fmaxf(fabsf(y.z), fabsf(y.w)))); }
            am = fmaxf(wave_max_fast(am), 1e-30f);
            const float inv = 127.f / am;
            GAS unsigned* h8 = (GAS unsigned*)(F.ws + WS_H + (size_t)m * D) + F.lane;
#pragma unroll
            for (int j = 0; j < 4; ++j) { const int q0 = (int)rintf(v[q][j].x * inv), q1 = (int)rintf(v[q][j].y * inv), q2 = (int)rintf(v[q][j].z * inv), q3 = (int)rintf(v[q][j].w * inv);
                h8[64 * j] = (unsigned)(q0 & 255) | ((unsigned)(q1 & 255) << 8) | ((unsigned)(q2 & 255) << 16) | ((unsigned)(q3 & 255) << 24); }
            if (F.lane == 0) ((float*)(F.ws + WS_RS))[m] = am * (1.f / 127.f);
        }
    }
}
struct EpiProj {
    static constexpr bool PERM = true, AFTER_DRAIN = false, LDS_SCALE = true;
    __device__ __forceinline__ const float* scale_base(const pg8::Unit& u, int wid) const { return wid < 4 ? RS + u.pm * 256 + wid * 64 : CS + u.pn * 256 + (wid - 4) * 64; }
    bf16* P; float* HD; const LAS float* lb; const float* RS; const float* CS;
    __device__ __forceinline__ void operator()(const pg8::f32x4 (&acc)[2][2][4][2], const pg8::Unit& u, int wr, int wc, int fr, int fq, const LAS float* scl) const {
        const int pn = u.pn, row0 = u.pm * 256 + wr * 64 + fr, cl = wc * 32 + 8 * fq;
        float rsc[2][4], csc[2][8];
#pragma unroll
        for (int ai = 0; ai < 2; ++ai)
#pragma unroll
            for (int mm = 0; mm < 4; ++mm) rsc[ai][mm] = scl[wr * 64 + fr + ai * 128 + mm * 16] * (1.f / 127.f);
#pragma unroll
        for (int bj = 0; bj < 2; ++bj)
#pragma unroll
            for (int i = 0; i < 8; ++i) csc[bj][i] = scl[256 + bj * 128 + cl + i];
#define DEQ(ai_, bj_, m_, n_, j_) ((float)(__builtin_bit_cast(pg8::i32x4, acc[ai_][bj_][m_][n_])[j_]) * rsc[ai_][m_] * csc[bj_][4 * (n_) + (j_)])
        if (pn >= 6 && pn < 10) {
            const int h = pn - 6;
            bf16* HQ = P + 3 * PSTRIDE; bf16* HK = P + 4 * PSTRIDE;
            float lbv[8];
#pragma unroll
            for (int i = 0; i < 8; ++i) lbv[i] = lb[h * 128 + cl + i];
#pragma unroll
            for (int ai = 0; ai < 2; ++ai) {
                float qt[4][8], kt[4][8], dl[8];
#pragma unroll
                for (int n = 0; n < 2; ++n)
#pragma unroll
                    for (int j = 0; j < 4; ++j) {
                        const int i = 4 * n + j; float carry = 1.f;
#pragma unroll
                        for (int m = 0; m < 4; ++m) {
                            const float aq = DEQ(ai, 0, m, n, j), af = DEQ(ai, 1, m, n, j);
                            const float f = lbv[i] + (1.f - lbv[i]) * sigmf(af);
                            float p = f;
                            p *= dpp_one<0x111>(p); p *= dpp_one<0x112>(p); p *= dpp_one<0x114>(p); p *= dpp_one<0x118>(p);
                            p *= carry; carry = __shfl(p, 15, 16);
                            qt[m][i] = siluf(aq) * p; kt[m][i] = (1.f - f) * __builtin_amdgcn_rcpf(p);
                            if (m == 3) dl[i] = p;
                        }
                    }
#pragma unroll
                for (int m = 0; m < 4; ++m) {
                    const size_t off = (size_t)(row0 + ai * 128 + m * 16) * 512 + h * 128 + cl;
                    v4u w; w.x = pk2(qt[m][0], qt[m][1]); w.y = pk2(qt[m][2], qt[m][3]); w.z = pk2(qt[m][4], qt[m][5]); w.w = pk2(qt[m][6], qt[m][7]);
                    *(GAS v4u*)(HQ + off) = w;
                    w.x = pk2(kt[m][0], kt[m][1]); w.y = pk2(kt[m][2], kt[m][3]); w.z = pk2(kt[m][4], kt[m][5]); w.w = pk2(kt[m][6], kt[m][7]);
                    *(GAS v4u*)(HK + off) = w;
                }
                if (fr == 15) { float* dp = HD + (size_t)(u.pm * 4 + ai * 2 + wr) * 512 + h * 128 + cl;
                    *(GAS f32x4*)dp = (f32x4){dl[0], dl[1], dl[2], dl[3]}; *(GAS f32x4*)(dp + 4) = (f32x4){dl[4], dl[5], dl[6], dl[7]}; }
            }
        } else {
            bf16* O = P + (size_t)(pn >> 1) * PSTRIDE;
            const int colt = (pn & 1) * 256 + cl;
            const float sc = pn < 2 ? QSCALE : 1.f;
            f32x2 c2[2][4];
#pragma unroll
            for (int bj = 0; bj < 2; ++bj)
#pragma unroll
                for (int q = 0; q < 4; ++q) c2[bj][q] = (f32x2){csc[bj][2 * q] * sc, csc[bj][2 * q + 1] * sc};
#pragma unroll
            for (int ai = 0; ai < 2; ++ai)
#pragma unroll
                for (int m = 0; m < 4; ++m) {
                    bf16* rowp = O + (size_t)(row0 + ai * 128 + m * 16) * 512 + colt;
                    const f32x2 rs2 = (f32x2){rsc[ai][m], rsc[ai][m]};
#pragma unroll
                    for (int bj = 0; bj < 2; ++bj) {
                        const pg8::i32x4 i0 = __builtin_bit_cast(pg8::i32x4, acc[ai][bj][m][0]), i1 = __builtin_bit_cast(pg8::i32x4, acc[ai][bj][m][1]);
                        f32x2 e0 = (f32x2){(float)i0[0], (float)i0[1]} * rs2 * c2[bj][0], e1 = (f32x2){(float)i0[2], (float)i0[3]} * rs2 * c2[bj][1];
                        f32x2 e2 = (f32x2){(float)i1[0], (float)i1[1]} * rs2 * c2[bj][2], e3 = (f32x2){(float)i1[2], (float)i1[3]} * rs2 * c2[bj][3];
                        if (pn >= 12) { e0 = (f32x2){siluf(e0.x), siluf(e0.y)}; e1 = (f32x2){siluf(e1.x), siluf(e1.y)}; e2 = (f32x2){siluf(e2.x), siluf(e2.y)}; e3 = (f32x2){siluf(e3.x), siluf(e3.y)}; }
                        v4u w; w.x = pk2(e0.x, e0.y); w.y = pk2(e1.x, e1.y); w.z = pk2(e2.x, e2.y); w.w = pk2(e3.x, e3.y);
                        *(GAS v4u*)(rowp + bj * 128) = w;
                    }
                }
        }
    }
};
namespace attn {
typedef unsigned u32x2 __attribute__((ext_vector_type(2)));
constexpr int NSLOT = 4, SLOT = 16384, KOFF = 0, VOFF = NSLOT * SLOT, SCR = LDSCTL_OFF + 4096;
constexpr float THR = 8.f;
__device__ __forceinline__ int crow(int r, int hi) { return (r & 3) + 8 * (r >> 2) + 4 * hi; }
__device__ __forceinline__ unsigned cvtpk(float lo, float hi) { typedef float f2 __attribute__((ext_vector_type(2))); typedef __bf16 b2 __attribute__((ext_vector_type(2)));
    f2 v = {lo, hi}; b2 b = __builtin_convertvector(v, b2); return __builtin_bit_cast(unsigned, b); }
typedef short v4i16_t __attribute__((ext_vector_type(4)));
__device__ __forceinline__ s16x4 vtr(LAS const unsigned char* p) { return __builtin_bit_cast(s16x4, __builtin_amdgcn_ds_read_tr16_b64_v4i16((LAS v4i16_t*)p)); }
__device__ __forceinline__ float max3f(float a, float b, float c) { float r; asm("v_max3_f32 %0, %1, %2, %3" : "=v"(r) : "v"(a), "v"(b), "v"(c)); return r; }
#define ATT_WAITBAR(N) asm volatile("s_waitcnt vmcnt(" #N ") lgkmcnt(0)\n\ts_barrier" ::: "memory")

__device__ __forceinline__ void attn_unit(int b, int h, int qb, const bf16* QA, const bf16* KA, const bf16* VA, bf16* CAT, const float lam, const float* g_sub, LAS unsigned char* lds) {
    const int tid = threadIdx.x, lane = tid & 63, r32 = lane & 31, hi = lane >> 5;
    const int wave = __builtin_amdgcn_readfirstlane(tid >> 6), rg = wave >> 1, j = wave & 1;
    const size_t rowbase = (size_t)b * S; const int q0 = qb * 128, R0 = q0 + 32 * rg;
    const int NT = (q0 + 128) / 64;
    unsigned goff[2];
#pragma unroll
    for (int i = 0; i < 2; ++i) { const int p = wave * 2 + i, row = 4 * p + (lane >> 4), chp = lane & 15, sw = ((row & 3) << 2) | ((row >> 2) & 3);
        goff[i] = (unsigned)(row * 1024 + ((chp ^ sw) << 4)); }
    const unsigned char* kbase = (const unsigned char*)(KA + rowbase * 512 + h * 128);
    const unsigned char* vbase = (const unsigned char*)(VA + rowbase * 512 + h * 128);
#define ATT_ISSUE_K(t) do { const size_t to_ = (size_t)(t) * 64 * 1024; _Pragma("unroll") for (int i_ = 0; i_ < 2; ++i_) \
        glds16(kbase + to_ + goff[i_], lds_addr(lds + KOFF + ((t) & 3) * SLOT + (wave * 2 + i_) * 1024)); } while (0)
#define ATT_ISSUE_V(t) do { const size_t to_ = (size_t)(t) * 64 * 1024; _Pragma("unroll") for (int i_ = 0; i_ < 2; ++i_) \
        glds16(vbase + to_ + goff[i_], lds_addr(lds + VOFF + ((t) & 3) * SLOT + (wave * 2 + i_) * 1024)); } while (0)
    int koffs[4];
    { const int sw = ((r32 & 3) << 2) | ((r32 >> 2) & 3);
#pragma unroll
      for (int ks = 0; ks < 4; ++ks) koffs[ks] = r32 * 256 + (((8 * j + 2 * ks + hi) ^ sw) << 4); }
    int voffs[2][4];
    { const int g = lane >> 4, i = lane & 15, qq = i >> 2, p = i & 3;
#pragma unroll
      for (int a = 0; a < 2; ++a)
#pragma unroll
          for (int db = 0; db < 4; ++db) voffs[a][db] = (8 * a + 4 * hi + qq) * 256 + ((((db ^ qq) << 2) | ((2 * (g & 1) + (p >> 1)) ^ ((2 * a + hi) & 3))) << 4) + 8 * (p & 1); }
    bf16x8 qr[4];
    { const bf16* qp = QA + (rowbase + R0 + r32) * 512 + h * 128 + j * 64 + hi * 8;
#pragma unroll
      for (int ks = 0; ks < 4; ++ks) qr[ks] = *(const GAS bf16x8*)(qp + ks * 16); }
    ATT_ISSUE_K(0); ATT_ISSUE_K(1); ATT_ISSUE_V(0); ATT_ISSUE_V(1); if (NT > 2) ATT_ISSUE_K(2);
    f32x16 o[4];
#pragma unroll
    for (int db = 0; db < 4; ++db) o[db] = (f32x16){0.f, 0.f, 0.f, 0.f, 0.f, 0.f, 0.f, 0.f, 0.f, 0.f, 0.f, 0.f, 0.f, 0.f, 0.f, 0.f};
    float m = -INFINITY, l = 0.f;
    LAS float* wsf = (LAS float*)(lds + SCR + wave * 256);
    const int last = (R0 + 31) >> 6;
#define ATT_LOADV(buf_, s_) do { _Pragma("unroll") for (int db = 0; db < 4; ++db) { \
        const s16x4 lo_ = vtr(Vs + (s_) * 4096 + voffs[0][db]), hh_ = vtr(Vs + (s_) * 4096 + voffs[1][db]); \
        vbuf[buf_][db] = (bf16x8){lo_[0], lo_[1], lo_[2], lo_[3], hh_[0], hh_[1], hh_[2], hh_[3]}; } } while (0)
    bf16x8 pa[4];
#define ATT_PV(Vs_) do { LAS const unsigned char* Vs = (Vs_); bf16x8 vbuf[2][4]; ATT_LOADV(0, 0); \
        _Pragma("unroll") for (int s = 0; s < 4; ++s) { if (s < 3) ATT_LOADV((s + 1) & 1, s + 1); __builtin_amdgcn_sched_barrier(0); \
            _Pragma("unroll") for (int db = 0; db < 4; ++db) o[db] = __builtin_amdgcn_mfma_f32_32x32x16_bf16(pa[s], vbuf[s & 1][db], o[db], 0, 0, 0); \
            __builtin_amdgcn_sched_barrier(0); } } while (0)
    typedef float f2 __attribute__((ext_vector_type(2)));
    int slot = 0;
#define ATT_HEAD(t_) do { if ((t_) + 1 == NT) { ATT_WAITBAR(0); } else if ((t_) + 2 < NT) { ATT_WAITBAR(4); } else { ATT_WAITBAR(2); } \
        if ((t_) + 2 < NT) ATT_ISSUE_V((t_) + 2); if ((t_) + 3 < NT) ATT_ISSUE_K((t_) + 3); } while (0)
#define ATT_SCORES(t_) \
        f32x16 p0 = (f32x16){0.f, 0.f, 0.f, 0.f, 0.f, 0.f, 0.f, 0.f, 0.f, 0.f, 0.f, 0.f, 0.f, 0.f, 0.f, 0.f}, p1 = p0; bool resc; \
        { \
          _Pragma("unroll") for (int ks = 0; ks < 4; ++ks) { \
              p0 = __builtin_amdgcn_mfma_f32_32x32x16_bf16(kf[2 * ks], qr[ks], p0, 0, 0, 0); \
              p1 = __builtin_amdgcn_mfma_f32_32x32x16_bf16(kf[2 * ks + 1], qr[ks], p1, 0, 0, 0); } \
          if (64 * (t_) + 63 > R0) { const int qrow = R0 + r32, k0_ = 64 * (t_); \
              _Pragma("unroll") for (int r = 0; r < 16; ++r) { const int kv = k0_ + crow(r, hi); if (kv > qrow) p0[r] = -INFINITY; if (kv + 32 > qrow) p1[r] = -INFINITY; } } \
          float rm = fmaxf(p0[0], p1[0]), rm2 = fmaxf(p0[1], p1[1]); \
          _Pragma("unroll") for (int r = 2; r < 16; r += 2) { rm = max3f(rm, p0[r], p1[r]); rm2 = max3f(rm2, p0[r + 1], p1[r + 1]); } \
          rm = fmaxf(rm, rm2); { const u32x2 sw_ = __builtin_amdgcn_permlane32_swap(__builtin_bit_cast(unsigned, rm), __builtin_bit_cast(unsigned, rm), false, false); rm = fmaxf(__builtin_bit_cast(float, sw_.x), __builtin_bit_cast(float, sw_.y)); } \
          resc = __any(rm > m + THR); \
          if (resc) { const float mn = fmaxf(m, rm), al = __builtin_amdgcn_exp2f(m - mn); m = mn; l *= al; if (hi == 0) wsf[r32] = al; } }
#define ATT_RESC_PACK() \
        if (resc) { LDS_WAIT(); \
            _Pragma("unroll") for (int g4 = 0; g4 < 4; ++g4) { const f32x4 a4 = *(LAS const f32x4*)(wsf + 8 * g4 + 4 * hi); \
                _Pragma("unroll") for (int db = 0; db < 4; ++db) { o[db][4 * g4] *= a4.x; o[db][4 * g4 + 1] *= a4.y; o[db][4 * g4 + 2] *= a4.z; o[db][4 * g4 + 3] *= a4.w; } } } \
        l += sacc2.x + sacc2.y; \
        _Pragma("unroll") for (int s = 0; s < 2; ++s) { v4u w0, w1; \
            w0.x = cvtpk(p0[8 * s], p0[8 * s + 1]); w0.y = cvtpk(p0[8 * s + 2], p0[8 * s + 3]); w0.z = cvtpk(p0[8 * s + 4], p0[8 * s + 5]); w0.w = cvtpk(p0[8 * s + 6], p0[8 * s + 7]); \
            w1.x = cvtpk(p1[8 * s], p1[8 * s + 1]); w1.y = cvtpk(p1[8 * s + 2], p1[8 * s + 3]); w1.z = cvtpk(p1[8 * s + 4], p1[8 * s + 5]); w1.w = cvtpk(p1[8 * s + 6], p1[8 * s + 7]); \
            pa[s] = __builtin_bit_cast(bf16x8, w0); pa[2 + s] = __builtin_bit_cast(bf16x8, w1); } \
        __builtin_amdgcn_sched_barrier(0);
    bf16x8 kf[8];
#define ATT_LOADK(slot_, ks_) do { LAS const unsigned char* Kn_ = lds + KOFF + (slot_) * SLOT; kf[2 * (ks_)] = *(LAS const bf16x8*)(Kn_ + koffs[ks_]); kf[2 * (ks_) + 1] = *(LAS const bf16x8*)(Kn_ + 8192 + koffs[ks_]); } while (0)
    {
        ATT_HEAD(0);
#pragma unroll
        for (int ks = 0; ks < 4; ++ks) ATT_LOADK(0, ks);
        __builtin_amdgcn_sched_barrier(0);
        ATT_SCORES(0)
#pragma unroll
        for (int ks = 0; ks < 4; ++ks) ATT_LOADK(1, ks);
        f2 sacc2 = (f2){0.f, 0.f};
#pragma unroll
        for (int r = 0; r < 16; ++r) { p0[r] = __builtin_amdgcn_exp2f(p0[r] - m); p1[r] = __builtin_amdgcn_exp2f(p1[r] - m); sacc2 += (f2){p0[r], p1[r]}; }
        ATT_RESC_PACK()
        slot = 1;
    }
#pragma unroll 1
    for (int t = 1; t <= last; ++t) {
        ATT_HEAD(t);
        ATT_SCORES(t)
        f2 sacc2 = (f2){0.f, 0.f};
        LAS const unsigned char* Vs = lds + VOFF + ((slot + 3) & 3) * SLOT;
#pragma unroll
        for (int s = 0; s < 4; ++s) {
            bf16x8 vb[4];
#pragma unroll
            for (int db = 0; db < 4; ++db) { const s16x4 lo_ = vtr(Vs + s * 4096 + voffs[0][db]), hh_ = vtr(Vs + s * 4096 + voffs[1][db]);
                vb[db] = (bf16x8){lo_[0], lo_[1], lo_[2], lo_[3], hh_[0], hh_[1], hh_[2], hh_[3]}; }
            __builtin_amdgcn_sched_barrier(0);
#pragma unroll
            for (int r = 4 * s; r < 4 * s + 4; ++r) { float e0 = __builtin_amdgcn_exp2f(p0[r] - m), e1 = __builtin_amdgcn_exp2f(p1[r] - m); asm volatile("" : "+v"(e0), "+v"(e1)); p0[r] = e0; p1[r] = e1; sacc2 += (f2){e0, e1}; }
            __builtin_amdgcn_sched_barrier(0);
#pragma unroll
            for (int db = 0; db < 4; ++db) o[db] = __builtin_amdgcn_mfma_f32_32x32x16_bf16(pa[s], vb[db], o[db], 0, 0, 0);
            ATT_LOADK((slot + 1) & 3, s);
            __builtin_amdgcn_sched_barrier(0);
        }
        ATT_RESC_PACK()
        slot = (slot + 1) & 3;
    }
#pragma unroll 1
    for (int t = last + 1; t < NT; ++t) {
        ATT_HEAD(t);
        if (t == last + 1) ATT_PV(lds + VOFF + ((slot + 3) & 3) * SLOT);
        slot = (slot + 1) & 3;
    }
    if (last == NT - 1) { ATT_PV(lds + VOFF + ((slot + 3) & 3) * SLOT); }
#undef ATT_HEAD
#undef ATT_LOADK
#undef ATT_SCORES
#undef ATT_RESC_PACK
#undef ATT_PV
#undef ATT_LOADV
    ATT_WAITBAR(0);
    l += __shfl_xor(l, 32);
    if (hi == 0) wsf[r32] = 1.f / l;
    LDS_WAIT();
#pragma unroll
    for (int g4 = 0; g4 < 4; ++g4) { const f32x4 a4 = *(LAS const f32x4*)(wsf + 8 * g4 + 4 * hi);
#pragma unroll
        for (int db = 0; db < 4; ++db) { o[db][4 * g4] *= a4.x; o[db][4 * g4 + 1] *= a4.y; o[db][4 * g4 + 2] *= a4.z; o[db][4 * g4 + 3] *= a4.w; } }
    LAS float* xch = (LAS float*)(lds + rg * 16384) + lane;
    if (j == 1) {
#pragma unroll
        for (int db = 0; db < 4; ++db)
#pragma unroll
            for (int r = 0; r < 16; ++r) xch[(db * 16 + r) * 64] = o[db][r];
    }
    ATT_WAITBAR(0);
    if (j == 0) {
        float gs[4];
#pragma unroll
        for (int db = 0; db < 4; ++db) gs[db] = g_sub[32 * db + r32] * (1.f - LAM_INIT);
#pragma unroll
        for (int db = 0; db < 4; ++db)
#pragma unroll
            for (int r = 0; r < 16; ++r) o[db][r] -= lam * xch[(db * 16 + r) * 64];
        bf16* cp = CAT + (rowbase + R0) * D + h * 128 + r32;
#pragma unroll
        for (int r = 0; r < 16; ++r) {
            float ss = (o[0][r] * o[0][r] + o[1][r] * o[1][r]) + (o[2][r] * o[2][r] + o[3][r] * o[3][r]);
            ss += __shfl_xor(ss, 1); ss += __shfl_xor(ss, 2); ss += __shfl_xor(ss, 4); ss += __shfl_xor(ss, 8); ss += __shfl_xor(ss, 16);
            const float rn = rsqrtf(ss * (1.f / 128.f) + EPS);
            bf16* rp = cp + (size_t)crow(r, hi) * D;
#pragma unroll
            for (int db = 0; db < 4; ++db) rp[32 * db] = (bf16)f2bf(o[db][r] * rn * gs[db]);
        }
    }
    ATT_WAITBAR(0);
#undef ATT_ISSUE_K
#undef ATT_ISSUE_V
}
__device__ __forceinline__ void attn_phase(Frame& F) {
    const bf16* P = (const bf16*)(F.ws + WS_P);
    const float lam = ((const float*)(F.ws + WS_MISC))[0];
    const int bh = F.vcu >> 3, s = F.vcu & 7;
    for (int i = 0; i < 4; ++i) {
        const int qb = (i == 0) ? s : (i == 1) ? 15 - s : (i == 2) ? 16 + s : 31 - s;
        attn_unit(bh >> 2, bh & 3, qb, P, P + PSTRIDE, P + 2 * PSTRIDE, (bf16*)(F.ws + WS_CAT), lam, F.in[I_GSUB], F.lds + RING_OFF);
    }
}
}
namespace hgrn {
using attn::crow; using attn::cvtpk; using attn::vtr;
constexpr int TILE = 16384;
#define HG_WAITBAR(N) asm volatile("s_waitcnt vmcnt(" #N ") lgkmcnt(0)\n\ts_barrier" ::: "memory")
struct Addr { unsigned goff[2]; int vb0, vb1, qq; };
__device__ __forceinline__ void make_addr(Addr& A, int wave, int lane, int npieces_per_wave_base) {
    const int hi = lane >> 5;
#pragma unroll
    for (int i = 0; i < 2; ++i) { const int p = npieces_per_wave_base + i, row = 4 * p + (lane >> 4), chp = lane & 15, sw = ((row & 3) << 2) | ((row >> 2) & 3);
        A.goff[i] = (unsigned)(row * 1024 + ((chp ^ sw) << 4)); }
    const int g = lane >> 4, i = lane & 15, qq = i >> 2, p = i & 3;
    A.qq = qq;
    A.vb0 = (4 * hi + qq) * 256 + (((2 * (g & 1) + (p >> 1)) ^ (hi & 3)) << 4) + 8 * (p & 1);
    A.vb1 = (8 + 4 * hi + qq) * 256 + (((2 * (g & 1) + (p >> 1)) ^ ((2 + hi) & 3)) << 4) + 8 * (p & 1);
}
__device__ __forceinline__ bf16x8 trfrag(LAS const unsigned char* tile, const Addr& A, int ss, int x) {
    const int xo = ((x ^ A.qq) & 3) << 6;
    const s16x4 lo = vtr(tile + ss * 4096 + A.vb0 + xo), hh = vtr(tile + ss * 4096 + A.vb1 + xo);
    return (bf16x8){lo[0], lo[1], lo[2], lo[3], hh[0], hh[1], hh[2], hh[3]};
}
__device__ __forceinline__ void pass_a(Frame& F) {
    LAS unsigned char* lds = F.lds + RING_OFF;
    const int lane = F.lane, wave = F.wave, r32 = lane & 31, hi = lane >> 5, sl = wave & 3, kh = wave >> 2;
    const int bh = F.vcu >> 3, sc = F.vcu & 7, b = bh >> 2, h = bh & 3;
    const size_t t0 = (size_t)b * S + sc * 512;
    const bf16* P = (const bf16*)(F.ws + WS_P);
    const unsigned char* kbase = (const unsigned char*)(P + 4 * PSTRIDE + t0 * 512 + h * 128);
    const unsigned char* vbase = (const unsigned char*)(P + 5 * PSTRIDE + t0 * 512 + h * 128);
    const float* HD = (const float*)(F.ws + WS_HD) + (size_t)(b * 64 + sc * 8) * 512 + h * 128;
    Addr A; make_addr(A, wave, lane, wave * 2);
    LAS float* hds = (LAS float*)(F.lds + HDS_OFF);
    *(LAS f32x2*)(hds + (F.tid >> 6) * 128 + 2 * (F.tid & 63)) = *(const GAS f32x2*)(HD + (size_t)(F.tid >> 6) * 512 + 2 * (F.tid & 63));
#define HGA_ISSUE(c, slot) do { const size_t to_ = (size_t)(c) * 64 * 1024; _Pragma("unroll") for (int i_ = 0; i_ < 2; ++i_) { \
        glds16(kbase + to_ + A.goff[i_], lds_addr(lds + (slot) * 2 * TILE + (wave * 2 + i_) * 1024)); \
        glds16(vbase + to_ + A.goff[i_], lds_addr(lds + (slot) * 2 * TILE + TILE + (wave * 2 + i_) * 1024)); } } while (0)
    HGA_ISSUE(0, 0); HGA_ISSUE(1, 1);
    f32x16 acc[2];
#pragma unroll
    for (int rb = 0; rb < 2; ++rb) acc[rb] = (f32x16){0.f, 0.f, 0.f, 0.f, 0.f, 0.f, 0.f, 0.f, 0.f, 0.f, 0.f, 0.f, 0.f, 0.f, 0.f, 0.f};
    int slot = 0;
    for (int c = 0; c < 8; ++c) {
        if (c + 1 < 8) { HG_WAITBAR(4); } else { HG_WAITBAR(0); }
        if (c + 2 < 8) { const int s2 = slot == 0 ? 2 : slot - 1; HGA_ISSUE(c + 2, s2); }
        LAS const unsigned char* KT = lds + slot * 2 * TILE; LAS const unsigned char* VT = KT + TILE;
#pragma unroll
        for (int ss = 0; ss < 4; ++ss) {
            const bf16x8 bfr = trfrag(VT, A, ss, sl);
#pragma unroll
            for (int rb = 0; rb < 2; ++rb) { const bf16x8 afr = trfrag(KT, A, ss, 2 * kh + rb); acc[rb] = __builtin_amdgcn_mfma_f32_32x32x16_bf16(afr, bfr, acc[rb], 0, 0, 0); }
        }
#pragma unroll
        for (int rb = 0; rb < 2; ++rb)
#pragma unroll
            for (int g4 = 0; g4 < 4; ++g4) { const f32x4 d4 = *(LAS const f32x4*)(hds + c * 128 + 32 * (2 * kh + rb) + 8 * g4 + 4 * hi);
                acc[rb][4 * g4] *= d4.x; acc[rb][4 * g4 + 1] *= d4.y; acc[rb][4 * g4 + 2] *= d4.z; acc[rb][4 * g4 + 3] *= d4.w; }
        slot = slot == 2 ? 0 : slot + 1;
    }
    float* L = (float*)(F.ws + WS_LSC) + (size_t)F.vcu * 16384;
#pragma unroll
    for (int rb = 0; rb < 2; ++rb)
#pragma unroll
        for (int r = 0; r < 16; ++r) L[(size_t)(32 * (2 * kh + rb) + crow(r, hi)) * 128 + 32 * sl + r32] = acc[rb][r];
    if (F.tid < 128) { float p = 1.f;
#pragma unroll
        for (int c = 0; c < 8; ++c) p *= hds[c * 128 + F.tid];
        ((float*)(F.ws + WS_DSC))[(size_t)F.vcu * 128 + F.tid] = p; }
    HG_WAITBAR(0);
#undef HGA_ISSUE
}
__device__ __forceinline__ void pass_c(Frame& F) {
    LAS unsigned char* lds = F.lds + RING_OFF;
    const int lane = F.lane, wave = F.wave, r32 = lane & 31, hi = lane >> 5, sl = wave & 3, th = wave >> 2;
    const int bh = F.vcu >> 3, sc = F.vcu & 7, b = bh >> 2, h = bh & 3;
    const size_t t0 = (size_t)b * S + sc * 512;
    const bf16* P = (const bf16*)(F.ws + WS_P);
    const unsigned char* qbase = (const unsigned char*)(P + 3 * PSTRIDE + t0 * 512 + h * 128);
    const unsigned char* kbase = (const unsigned char*)(P + 4 * PSTRIDE + t0 * 512 + h * 128);
    const unsigned char* vbase = (const unsigned char*)(P + 5 * PSTRIDE + t0 * 512 + h * 128);
    const bf16* HG = P + 6 * PSTRIDE;
    const float* HD = (const float*)(F.ws + WS_HD) + (size_t)(b * 64 + sc * 8) * 512 + h * 128;
    const float* g_out = F.in[I_GHOUT];
    bf16* CAT = (bf16*)(F.ws + WS_CAT);
    Addr A; make_addr(A, wave, lane, wave * 2);
    constexpr int SLOTB = 3 * TILE, OST = 2 * SLOTB;
#define HGC_ISSUE(c, slot) do { const size_t to_ = (size_t)(c) * 64 * 1024; _Pragma("unroll") for (int i_ = 0; i_ < 2; ++i_) { \
        glds16(qbase + to_ + A.goff[i_], lds_addr(lds + (slot) * SLOTB + (wave * 2 + i_) * 1024)); \
        glds16(kbase + to_ + A.goff[i_], lds_addr(lds + (slot) * SLOTB + TILE + (wave * 2 + i_) * 1024)); \
        glds16(vbase + to_ + A.goff[i_], lds_addr(lds + (slot) * SLOTB + 2 * TILE + (wave * 2 + i_) * 1024)); } } while (0)
    LAS float* hds = (LAS float*)(F.lds + HDS_OFF);
    *(LAS f32x2*)(hds + (F.tid >> 6) * 128 + 2 * (F.tid & 63)) = *(const GAS f32x2*)(HD + (size_t)(F.tid >> 6) * 512 + 2 * (F.tid & 63));
    HGC_ISSUE(0, 0);
    f32x16 st[4];
#pragma unroll
    for (int kb = 0; kb < 4; ++kb) st[kb] = (f32x16){0.f, 0.f, 0.f, 0.f, 0.f, 0.f, 0.f, 0.f, 0.f, 0.f, 0.f, 0.f, 0.f, 0.f, 0.f, 0.f};
    for (int i = 0; i < sc; ++i) {
        const float* L = (const float*)(F.ws + WS_LSC) + (size_t)(bh * 8 + i) * 16384;
        const float* Dt = (const float*)(F.ws + WS_DSC) + (size_t)(bh * 8 + i) * 128;
#pragma unroll
        for (int kb = 0; kb < 4; ++kb)
#pragma unroll
            for (int g4 = 0; g4 < 4; ++g4) { const f32x4 d4 = *(const GAS f32x4*)(Dt + 32 * kb + 8 * g4 + 4 * hi);
#pragma unroll
                for (int e = 0; e < 4; ++e) { const int r = 4 * g4 + e; st[kb][r] = st[kb][r] * d4[e] + L[(size_t)(32 * kb + crow(r, hi)) * 128 + 32 * sl + r32]; } }
    }
    float go[16];
#pragma unroll
    for (int e4 = 0; e4 < 4; ++e4) { const f32x4 gq = *(const f32x4*)(g_out + (lane & 7) * 16 + 4 * e4); go[4 * e4] = gq.x; go[4 * e4 + 1] = gq.y; go[4 * e4 + 2] = gq.z; go[4 * e4 + 3] = gq.w; }
    const int swq = ((r32 & 3) << 2) | ((r32 >> 2) & 3);
    for (int c = 0; c < 8; ++c) {
        const int slot = c & 1;
        HG_WAITBAR(0);
        const size_t grow = t0 + (size_t)c * 64 + 8 * wave + (lane >> 3);
        const v4u g0 = *(const GAS v4u*)(HG + grow * 512 + h * 128 + (lane & 7) * 16), g1 = *(const GAS v4u*)(HG + grow * 512 + h * 128 + (lane & 7) * 16 + 8);
        if (c + 1 < 8) HGC_ISSUE(c + 1, slot ^ 1);
        LAS const unsigned char* QT = lds + slot * SLOTB; LAS const unsigned char* KT = QT + TILE; LAS const unsigned char* VT = QT + 2 * TILE;
        f32x16 X0 = (f32x16){0.f, 0.f, 0.f, 0.f, 0.f, 0.f, 0.f, 0.f, 0.f, 0.f, 0.f, 0.f, 0.f, 0.f, 0.f, 0.f}, X1 = X0;
#pragma unroll
        for (int kk = 0; kk < 8; ++kk) {
            const int co = ((2 * kk + hi) ^ swq) << 4;
            const bf16x8 qf = *(LAS const bf16x8*)(QT + (32 * th + r32) * 256 + co);
            const bf16x8 k0 = *(LAS const bf16x8*)(KT + r32 * 256 + co);
            X0 = __builtin_amdgcn_mfma_f32_32x32x16_bf16(k0, qf, X0, 0, 0, 0);
            if (th == 1) { const bf16x8 k1 = *(LAS const bf16x8*)(KT + (32 + r32) * 256 + co); X1 = __builtin_amdgcn_mfma_f32_32x32x16_bf16(k1, qf, X1, 0, 0, 0); }
        }
        if (th == 0) {
#pragma unroll
            for (int r = 0; r < 16; ++r) if (crow(r, hi) > r32) X0[r] = 0.f;
        } else {
#pragma unroll
            for (int r = 0; r < 16; ++r) if (crow(r, hi) > r32) X1[r] = 0.f;
        }
        bf16x8 vf[4];
#pragma unroll
        for (int ss = 0; ss < 4; ++ss) vf[ss] = trfrag(VT, A, ss, sl);
        f32x16 o = (f32x16){0.f, 0.f, 0.f, 0.f, 0.f, 0.f, 0.f, 0.f, 0.f, 0.f, 0.f, 0.f, 0.f, 0.f, 0.f, 0.f};
#pragma unroll
        for (int s2 = 0; s2 < 2; ++s2) { v4u w; w.x = cvtpk(X0[8 * s2], X0[8 * s2 + 1]); w.y = cvtpk(X0[8 * s2 + 2], X0[8 * s2 + 3]); w.z = cvtpk(X0[8 * s2 + 4], X0[8 * s2 + 5]); w.w = cvtpk(X0[8 * s2 + 6], X0[8 * s2 + 7]);
            o = __builtin_amdgcn_mfma_f32_32x32x16_bf16(__builtin_bit_cast(bf16x8, w), vf[s2], o, 0, 0, 0); }
        if (th == 1) {
#pragma unroll
            for (int s2 = 0; s2 < 2; ++s2) { v4u w; w.x = cvtpk(X1[8 * s2], X1[8 * s2 + 1]); w.y = cvtpk(X1[8 * s2 + 2], X1[8 * s2 + 3]); w.z = cvtpk(X1[8 * s2 + 4], X1[8 * s2 + 5]); w.w = cvtpk(X1[8 * s2 + 6], X1[8 * s2 + 7]);
                o = __builtin_amdgcn_mfma_f32_32x32x16_bf16(__builtin_bit_cast(bf16x8, w), vf[2 + s2], o, 0, 0, 0); }
        }
#pragma unroll
        for (int kk = 0; kk < 8; ++kk) {
            const int kb = kk >> 1, s2 = kk & 1;
            v4u w; w.x = cvtpk(st[kb][8 * s2], st[kb][8 * s2 + 1]); w.y = cvtpk(st[kb][8 * s2 + 2], st[kb][8 * s2 + 3]); w.z = cvtpk(st[kb][8 * s2 + 4], st[kb][8 * s2 + 5]); w.w = cvtpk(st[kb][8 * s2 + 6], st[kb][8 * s2 + 7]);
            LAS const unsigned char* qrow = QT + (32 * th + r32) * 256 + 8 * hi;
            const v2u q0 = *(LAS const v2u*)(qrow + (((2 * kk) ^ swq) << 4)), q1 = *(LAS const v2u*)(qrow + (((2 * kk + 1) ^ swq) << 4));
            const v4u qa = (v4u){q0.x, q0.y, q1.x, q1.y};
            o = __builtin_amdgcn_mfma_f32_32x32x16_bf16(__builtin_bit_cast(bf16x8, qa), __builtin_bit_cast(bf16x8, w), o, 0, 0, 0);
        }
#pragma unroll
        for (int ss = 0; ss < 4; ++ss)
#pragma unroll
            for (int kb = 0; kb < 4; ++kb) { const bf16x8 afr = trfrag(KT, A, ss, kb); st[kb] = __builtin_amdgcn_mfma_f32_32x32x16_bf16(afr, vf[ss], st[kb], 0, 0, 0); }
#pragma unroll
        for (int kb = 0; kb < 4; ++kb)
#pragma unroll
            for (int g4 = 0; g4 < 4; ++g4) { const f32x4 d4 = *(LAS const f32x4*)(hds + c * 128 + 32 * kb + 8 * g4 + 4 * hi);
                st[kb][4 * g4] *= d4.x; st[kb][4 * g4 + 1] *= d4.y; st[kb][4 * g4 + 2] *= d4.z; st[kb][4 * g4 + 3] *= d4.w; }
        LAS float* ost = (LAS float*)(lds + OST);
#pragma unroll
        for (int r = 0; r < 16; ++r) ost[(32 * th + crow(r, hi)) * 128 + 32 * sl + r32] = o[r];
        asm volatile("s_waitcnt lgkmcnt(0)\n\ts_barrier" ::: "memory");
        {
            const int row = 8 * wave + (lane >> 3), c0 = (lane & 7) * 16;
            float v[16]; float ss = 0.f;
#pragma unroll
            for (int e4 = 0; e4 < 4; ++e4) { const f32x4 x = *(LAS const f32x4*)(ost + row * 128 + c0 + 4 * e4); v[4 * e4] = x.x; v[4 * e4 + 1] = x.y; v[4 * e4 + 2] = x.z; v[4 * e4 + 3] = x.w;
                ss += (x.x * x.x + x.y * x.y) + (x.z * x.z + x.w * x.w); }
            ss += __shfl_xor(ss, 1); ss += __shfl_xor(ss, 2); ss += __shfl_xor(ss, 4);
            const float rn = rsqrtf(ss * (1.f / 128.f) + EPS);
            const size_t trow = t0 + (size_t)c * 64 + row;
            const unsigned gw[8] = {g0.x, g0.y, g0.z, g0.w, g1.x, g1.y, g1.z, g1.w};
            unsigned ow[8];
#pragma unroll
            for (int e = 0; e < 8; ++e) { const float a = v[2 * e] * rn * go[2 * e] * bflo(gw[e]), bb = v[2 * e + 1] * rn * go[2 * e + 1] * bfhi(gw[e]); ow[e] = pk2(a, bb); }
            bf16* op = CAT + trow * D + 512 + h * 128 + c0;
            *(GAS v4u*)op = (v4u){ow[0], ow[1], ow[2], ow[3]}; *(GAS v4u*)(op + 8) = (v4u){ow[4], ow[5], ow[6], ow[7]};
        }
    }
    HG_WAITBAR(0);
#undef HGC_ISSUE
}
}
struct EpiBf16 {
    static constexpr bool PERM = true, AFTER_DRAIN = false, LDS_SCALE = false;
    bf16* O; int ldc;
    __device__ __forceinline__ void operator()(const pg8::f32x4 (&acc)[2][2][4][2], const pg8::Unit& u, int wr, int wc, int fr, int fq) const {
        const int row0 = u.pm * 256 + wr * 64 + fr, col0 = u.pn * 256 + wc * 32 + 8 * fq;
#pragma unroll
        for (int ai = 0; ai < 2; ++ai)
#pragma unroll
            for (int m = 0; m < 4; ++m) { bf16* rowp = O + (size_t)(row0 + ai * 128 + m * 16) * ldc + col0;
#pragma unroll
                for (int bj = 0; bj < 2; ++bj) { const pg8::f32x4 v0 = acc[ai][bj][m][0], v1 = acc[ai][bj][m][1];
                    v4u w; w.x = pk2(v0[0], v0[1]); w.y = pk2(v0[2], v0[3]); w.z = pk2(v1[0], v1[1]); w.w = pk2(v1[2], v1[3]);
                    *(GAS v4u*)(rowp + bj * 128) = w; } }
    }
};
struct EpiBf16I8 {
    static constexpr bool PERM = true, AFTER_DRAIN = false, LDS_SCALE = true;
    __device__ __forceinline__ const float* scale_base(const pg8::Unit& u, int wid) const { return wid < 4 ? RS + u.pm * 256 + wid * 64 : CS + u.pn * 256 + (wid - 4) * 64; }
    bf16* O; int ldc; const float* RS; const float* CS;
    __device__ __forceinline__ void operator()(const pg8::f32x4 (&acc)[2][2][4][2], const pg8::Unit& u, int wr, int wc, int fr, int fq, const LAS float* scl) const {
        const int row0 = u.pm * 256 + wr * 64 + fr, col0 = u.pn * 256 + wc * 32 + 8 * fq;
        f32x2 c2[2][4];
#pragma unroll
        for (int bj = 0; bj < 2; ++bj)
#pragma unroll
            for (int q = 0; q < 4; ++q) c2[bj][q] = (f32x2){scl[256 + bj * 128 + wc * 32 + 8 * fq + 2 * q], scl[256 + bj * 128 + wc * 32 + 8 * fq + 2 * q + 1]};
#pragma unroll
        for (int ai = 0; ai < 2; ++ai)
#pragma unroll
            for (int m = 0; m < 4; ++m) { const float rs = scl[wr * 64 + fr + ai * 128 + m * 16] * (1.f / 127.f); bf16* rowp = O + (size_t)(row0 + ai * 128 + m * 16) * ldc + col0;
                const f32x2 rs2 = (f32x2){rs, rs};
#pragma unroll
                for (int bj = 0; bj < 2; ++bj) { const pg8::i32x4 i0 = __builtin_bit_cast(pg8::i32x4, acc[ai][bj][m][0]), i1 = __builtin_bit_cast(pg8::i32x4, acc[ai][bj][m][1]);
                    const f32x2 e0 = (f32x2){(float)i0[0], (float)i0[1]} * rs2 * c2[bj][0], e1 = (f32x2){(float)i0[2], (float)i0[3]} * rs2 * c2[bj][1];
                    const f32x2 e2 = (f32x2){(float)i1[0], (float)i1[1]} * rs2 * c2[bj][2], e3 = (f32x2){(float)i1[2], (float)i1[3]} * rs2 * c2[bj][3];
                    v4u w; w.x = pk2(e0.x, e0.y); w.y = pk2(e1.x, e1.y); w.z = pk2(e2.x, e2.y); w.w = pk2(e3.x, e3.y);
                    *(GAS v4u*)(rowp + bj * 128) = w; } }
    }
};
__device__ __forceinline__ void p_mid(Frame& F) {
    const int gw = F.vcu * NWAVES + F.wave, NGW = F.G * NWAVES;
    const float* x = F.in[I_X]; const float* gpost = F.in[I_GPOST1]; const float* gpre = F.in[I_GPRE2];
    const float* mod = (const float*)(F.ws + WS_MOD); const bf16* Y = (const bf16*)(F.ws + WS_Y);
    f32x4 pgg[4], pgt[4], pg2[4], psc[4], psh[4];
    { const float* mb = mod + ((16 * gw) / S) * NMOD;
#pragma unroll
      for (int j = 0; j < 4; ++j) { const int col = (F.lane + 64 * j) * 4; pgg[j] = *(const f32x4*)(gpost + col); pgt[j] = *(const f32x4*)(mb + 2 * D + col);
          pg2[j] = *(const f32x4*)(gpre + col); psc[j] = 1.f + *(const f32x4*)(mb + 4 * D + col); psh[j] = *(const f32x4*)(mb + 3 * D + col); } }
#pragma unroll 1
    for (int m0 = 16 * gw; m0 < 16 * gw + 16; m0 += 4) {
        f32x4 xv[4][4]; v2u yw[4][4];
#pragma unroll
        for (int q = 0; q < 4; ++q) { const GAS f32x4* xr = (const GAS f32x4*)(x + (size_t)(m0 + q) * D) + F.lane; const GAS v2u* yr = (const GAS v2u*)(Y + (size_t)(m0 + q) * D) + F.lane;
#pragma unroll
            for (int j = 0; j < 4; ++j) { xv[q][j] = __builtin_nontemporal_load(xr + 64 * j); yw[q][j] = __builtin_nontemporal_load(yr + 64 * j); } }
#pragma unroll
        for (int q = 0; q < 4; ++q) {
            const int m = m0 + q;
            f32x4 yv[4]; float ss = 0.f;
#pragma unroll
            for (int j = 0; j < 4; ++j) { const v2u w = yw[q][j]; yv[j] = (f32x4){bflo(w.x), bfhi(w.x), bflo(w.y), bfhi(w.y)};
                ss += (yv[j].x * yv[j].x + yv[j].y * yv[j].y) + (yv[j].z * yv[j].z + yv[j].w * yv[j].w); }
            const float r = rsqrtf(wave_sum_fast(ss) * (1.f / D) + EPS);
            float s2 = 0.f;
#pragma unroll
            for (int j = 0; j < 4; ++j) {
                xv[q][j] = xv[q][j] + pgt[j] * yv[j] * r * pgg[j];
                *((GAS v2u*)(F.ws + WS_X1B + (size_t)m * D * 2) + F.lane + 64 * j) = (v2u){pk2(xv[q][j].x, xv[q][j].y), pk2(xv[q][j].z, xv[q][j].w)};
                s2 += (xv[q][j].x * xv[q][j].x + xv[q][j].y * xv[q][j].y) + (xv[q][j].z * xv[q][j].z + xv[q][j].w * xv[q][j].w); }
            const float r2 = rsqrtf(wave_sum_fast(s2) * (1.f / D) + EPS);
            float am = 0.f;
#pragma unroll
            for (int j = 0; j < 4; ++j) {
                const f32x4 y = xv[q][j] * r2 * pg2[j] * psc[j] + psh[j]; xv[q][j] = y;
                am = fmaxf(am, fmaxf(fmaxf(fabsf(y.x), fabsf(y.y)), fmaxf(fabsf(y.z), fabsf(y.w)))); }
            am = fmaxf(wave_max_fast(am), 1e-30f);
            const float inv = 127.f / am;
            GAS unsigned* h8 = (GAS unsigned*)(F.ws + WS_H8 + (size_t)m * D) + F.lane;
#pragma unroll
            for (int j = 0; j < 4; ++j) { const int q0 = (int)rintf(xv[q][j].x * inv), q1 = (int)rintf(xv[q][j].y * inv), q2 = (int)rintf(xv[q][j].z * inv), q3 = (int)rintf(xv[q][j].w * inv);
                h8[64 * j] = (unsigned)(q0 & 255) | ((unsigned)(q1 & 255) << 8) | ((unsigned)(q2 & 255) << 16) | ((unsigned)(q3 & 255) << 24); }
            if (F.lane == 0) ((float*)(F.ws + WS_HS))[m] = am * (1.f / 127.f);
        }
    }
}
namespace topk {
using attn::crow;
__device__ __forceinline__ float keyf(float v, unsigned clr, unsigned code) { return __builtin_bit_cast(float, (__builtin_bit_cast(unsigned, v) & ~clr) | code); }
__device__ __forceinline__ float keyval(float k, unsigned clr) { return __builtin_bit_cast(float, __builtin_bit_cast(unsigned, k) & ~clr); }
__device__ __forceinline__ unsigned keycode(float k, unsigned clr) { return __builtin_bit_cast(unsigned, k) & clr; }
__device__ __forceinline__ void cas_desc(float& a, float& b) { const float hi = fmaxf(a, b), lo = fminf(a, b); a = hi; b = lo; }
struct Net16 { int i[63], j[63]; };
constexpr Net16 make_net16() { Net16 n{}; const int p[63][2] = {{0,1},{2,3},{0,2},{1,3},{1,2},{4,5},{6,7},{4,6},{5,7},{5,6},{0,4},{2,6},{2,4},{1,5},{3,7},{3,5},{1,2},{3,4},{5,6},{8,9},{10,11},{8,10},{9,11},{9,10},{12,13},{14,15},{12,14},{13,15},{13,14},{8,12},{10,14},{10,12},{9,13},{11,15},{11,13},{9,10},{11,12},{13,14},{0,8},{4,12},{4,8},{2,10},{6,14},{6,10},{2,4},{6,8},{10,12},{1,9},{5,13},{5,9},{3,11},{7,15},{7,11},{3,5},{7,9},{11,13},{1,2},{3,4},{5,6},{7,8},{9,10},{11,12},{13,14}};
    for (int k = 0; k < 63; ++k) { n.i[k] = p[k][0]; n.j[k] = p[k][1]; } return n; }
constexpr Net16 NET16 = make_net16();
template <int OFF> __device__ __forceinline__ void sort16_desc(float (&a)[64]) {
#pragma unroll
    for (int k = 0; k < 63; ++k) cas_desc(a[OFF + NET16.i[k]], a[OFF + NET16.j[k]]);
}
template <int OFF> __device__ __forceinline__ void merge16_desc(float (&a)[64]) {
#pragma unroll
    for (int j = 8; j > 0; j >>= 1)
#pragma unroll
        for (int i = 0; i < 16; ++i) { const int l = i ^ j; if (l > i) cas_desc(a[OFF + i], a[OFF + l]); }
}
template <int A, int B> __device__ __forceinline__ void top16(float (&a)[64]) {
#pragma unroll
    for (int i = 0; i < 16; ++i) a[A + i] = fmaxf(a[A + i], a[B + 15 - i]);
    merge16_desc<A>(a);
}
__device__ __forceinline__ void xlane_top16(float (&a)[64]) {
#pragma unroll
    for (int i = 0; i < 16; ++i) a[16 + i] = __shfl_xor(a[i], 32);
    top16<0, 16>(a);
}
struct Stair { int a[50], b[50]; };
constexpr Stair make_stair() { Stair s{}; int n = 0; for (int a = 0; a < 16; ++a) for (int b = 0; b < 16; ++b) if ((a + 1) * (b + 1) <= 16) { s.a[n] = a; s.b[n] = b; ++n; } return s; }
constexpr Stair STAIR = make_stair();

__device__ __forceinline__ void q_dma(const bf16* qblk  , unsigned qdst, int lane) {
#pragma unroll
    for (int j = 0; j < 8; ++j) { const int row = 4 * j + (lane >> 4), c = (lane & 15) ^ (row & 15);
        glds16(qblk + (size_t)row * NPQ + 8 * c, qdst + j * 1024); }
}
__device__ __forceinline__ void q_frag(LAS const unsigned char* qb, int r32, int hi, bf16x8 (&bq)[8]) {
    asm volatile("s_waitcnt vmcnt(0)" ::: "memory");
#pragma unroll
    for (int kk = 0; kk < 8; ++kk) bq[kk] = *(LAS const bf16x8*)(qb + r32 * 256 + (((2 * kk + hi) ^ (r32 & 15)) << 4));
    LDS_WAIT(); asm volatile("" ::: "memory");
}
__device__ __forceinline__ void half_top16(const bf16x8 (&bq)[8], LAS const unsigned char* kimg, int r32, int hi, float (&val)[16], int (&idx)[16]) {
    f32x16 acc[4];
#pragma unroll
    for (int kb = 0; kb < 4; ++kb) acc[kb] = (f32x16){0.f, 0.f, 0.f, 0.f, 0.f, 0.f, 0.f, 0.f, 0.f, 0.f, 0.f, 0.f, 0.f, 0.f, 0.f, 0.f};
    const int sw = ((r32 & 3) << 2) | ((r32 >> 2) & 3);
#pragma unroll
    for (int kk = 0; kk < 8; ++kk)
#pragma unroll
        for (int kb = 0; kb < 4; ++kb) { const bf16x8 ak = *(LAS const bf16x8*)(kimg + (32 * kb + r32) * 256 + (((2 * kk + hi) ^ sw) << 4));
            acc[kb] = __builtin_amdgcn_mfma_f32_32x32x16_bf16(ak, bq[kk], acc[kb], 0, 0, 0); }
    float a[64];
    const unsigned h4 = 4u * (unsigned)hi;
#pragma unroll
    for (int kb = 0; kb < 4; ++kb)
#pragma unroll
        for (int r = 0; r < 16; ++r) a[16 * kb + r] = keyf(acc[kb][r], 127u, (unsigned)(127 - 32 * kb - (r & 3) - 8 * (r >> 2)) - h4);
    sort16_desc<0>(a); sort16_desc<16>(a); sort16_desc<32>(a); sort16_desc<48>(a);
    top16<0, 16>(a); top16<32, 48>(a); top16<0, 32>(a);
    xlane_top16(a);
#pragma unroll
    for (int i = 0; i < 16; ++i) { val[i] = keyval(a[i], 127u); idx[i] = 127 - (int)keycode(a[i], 127u); }
}
__device__ __forceinline__ void phase(Frame& F) {
    LAS unsigned char* lds = F.lds + RING_OFF;
    const int lane = F.lane, wave = F.wave, r32 = lane & 31, hi = lane >> 5;
    const int hd = F.vcu & 7, grp = F.vcu >> 3;
    const bf16* Q = (const bf16*)(F.ws + WS_Q);
    int* pidx = (int*)(F.ws + WS_PIDX); float* pgate = (float*)(F.ws + WS_PGATE);
    { const unsigned char* kb = (const unsigned char*)(F.ws + WS_KEYS) + (size_t)hd * 2 * 32768;
#pragma unroll
      for (int i = 0; i < 8; ++i) { const int p = wave * 8 + i, row = 4 * (p & 31) + (lane >> 4), chp = lane & 15, sw = ((row & 3) << 2) | ((row >> 2) & 3);
          __builtin_amdgcn_global_load_lds((const unsigned*)(kb + (size_t)(p >> 5) * 32768 + row * 256 + ((chp ^ sw) << 4)), (LAS unsigned*)(lds + p * 1024), 16, 0, 0); }
      q_dma(Q + (size_t)(((grp * 32) + wave * 4) * 32) * NPQ + hd * 256, lds_addr(lds + 65536 + wave * 8192), lane);
      asm volatile("s_waitcnt vmcnt(0)\n\ts_barrier" ::: "memory"); }
    LAS unsigned char* tab = F.lds + TOPK_TAB_OFF + wave * 2048 + lane;
    LAS const unsigned char* qb = lds + 65536 + wave * 8192;
    const unsigned qdst = lds_addr(qb);
    for (int it = 0; it < 4; ++it) {
        const int t0 = ((grp * 32) + wave * 4 + it) * 32, t0n = ((grp * 32) + wave * 4 + (it < 3 ? it + 1 : 3)) * 32;
        float v1[16], v2[16]; int i1[16], i2[16];
        const int trow = (F.vcu * NWAVES + wave) + 4 * it * (F.G * NWAVES), tstr = F.G * NWAVES;
        { bf16x8 bq[8]; q_frag(qb, r32, hi, bq);
          q_dma(Q + (size_t)t0 * NPQ + hd * 256 + 128, qdst, lane);
          half_top16(bq, lds, r32, hi, v1, i1); }
        { bf16x8 bq[8]; q_frag(qb, r32, hi, bq);
          q_dma(Q + (size_t)t0n * NPQ + hd * 256, qdst, lane);
          half_top16(bq, lds + 32768, r32, hi, v2, i2); }
        f32x4 ta[4], tb[4], tc[4], td[4]; tab_load(F, trow, ta); tab_load(F, trow + tstr, tb); tab_load(F, trow + 2 * tstr, tc); tab_load(F, trow + 3 * tstr, td);
#pragma unroll
        for (int i = 0; i < 16; ++i) { tab[i * 64] = (unsigned char)i1[i]; tab[(16 + i) * 64] = (unsigned char)i2[i]; }
        float c[64];
#pragma unroll
        for (int n = 0; n < 32; ++n) {
            if (n < 25) { const int a0 = STAIR.a[2 * n], b0 = STAIR.b[2 * n], a1 = STAIR.a[2 * n + 1], b1 = STAIR.b[2 * n + 1];
                const float k0 = keyf(v1[a0] + v2[b0], 255u, (unsigned)(255 - (a0 * 16 + b0))), k1 = keyf(v1[a1] + v2[b1], 255u, (unsigned)(255 - (a1 * 16 + b1)));
                c[n] = hi ? k1 : k0; }
            else c[n] = -INFINITY;
        }
        sort16_desc<0>(c); sort16_desc<16>(c); top16<0, 16>(c); xlane_top16(c);
        LDS_WAIT();
        {
            int ex[16];
#pragma unroll
            for (int i = 0; i < 16; ++i) { const int pos = 255 - (int)keycode(c[i], 255u); ex[i] = (int)tab[(pos >> 4) * 64] * 128 + (int)tab[(16 + (pos & 15)) * 64]; }
            const float mx = keyval(c[0], 255u); float e[16], s = 0.f;
#pragma unroll
            for (int i = 0; i < 16; ++i) { e[i] = __expf(keyval(c[i], 255u) - mx); s += e[i]; }
            const float inv = 1.f / s;
            unsigned w[16];
#pragma unroll
            for (int i = 0; i < 16; ++i) w[i] = hi ? __builtin_bit_cast(unsigned, e[i] * inv) : (unsigned)ex[i];
            unsigned* dst = (hi ? (unsigned*)pgate : (unsigned*)pidx) + (size_t)(t0 + r32) * 128 + hd * 16;
#pragma unroll
            for (int g4 = 0; g4 < 4; ++g4) *(GAS v4u*)(dst + 4 * g4) = (v4u){w[4 * g4], w[4 * g4 + 1], w[4 * g4 + 2], w[4 * g4 + 3]};
        }
        tab_finish(F, trow + 2 * tstr, tc); tab_finish(F, trow + 3 * tstr, td);
        {
          tab_finish(F, trow, ta); tab_finish(F, trow + tstr, tb); }
        LDS_WAIT();
    }
    asm volatile("s_waitcnt vmcnt(0) lgkmcnt(0)\n\ts_barrier" ::: "memory");
}
}
namespace peer {
typedef float f32x2 __attribute__((ext_vector_type(2)));
template <int CTRL> __device__ __forceinline__ int dpp_i(int v) { return __builtin_amdgcn_update_dpp(0, v, CTRL, 0xf, 0xf, true); }
__device__ __forceinline__ int dot16(const v4u u, const v4u h) {
    int acc = __builtin_amdgcn_sdot4((int)u.x, (int)h.x, 0, false);
    acc = __builtin_amdgcn_sdot4((int)u.y, (int)h.y, acc, false);
    acc = __builtin_amdgcn_sdot4((int)u.z, (int)h.z, acc, false);
    return __builtin_amdgcn_sdot4((int)u.w, (int)h.w, acc, false);
}
__device__ __forceinline__ void axpy4(f32x2 (&y)[8], int o, unsigned v, float w) {
    const f32x2 ww = (f32x2){w, w};
    y[o] += ww * (f32x2){(float)(v & 0xff), (float)((v >> 8) & 0xff)};
    y[o + 1] += ww * (f32x2){(float)((v >> 16) & 0xff), (float)(v >> 24)};
}
constexpr int PFU = 8;
constexpr int PFV = 8;
constexpr int PF = 16;
constexpr int TOKWG = 128;
__device__ __forceinline__ void phase(Frame& F) {
    const int lane = F.lane, wave = F.wave, g = lane >> 3, sub = lane & 7;
    const int x = F.vcu >> 5, tokbase = F.vcu * TOKWG;
    LAS int* IDX = (LAS int*)(F.lds + RING_OFF);
    LAS int* AT = (LAS int*)(F.lds + RING_OFF + 65536);
    LAS float* WT = (LAS float*)(F.lds + LDSCTL_OFF + 4096);
    const unsigned char* EU = (const unsigned char*)(F.ws + WS_EU8); const unsigned char* EV = (const unsigned char*)(F.ws + WS_EV8);
    const f32x2* SUV = (const f32x2*)(F.ws + WS_SU); const float* HS = (const float*)(F.ws + WS_HS);
    const int* pidx = (const int*)(F.ws + WS_PIDX); const float* pgate = (const float*)(F.ws + WS_PGATE);
    bf16* Y2 = (bf16*)(F.ws + WS_Y2);
    { v4u tmp[8];
#pragma unroll
      for (int q = 0; q < 8; ++q) tmp[q] = __builtin_nontemporal_load((const GAS v4u*)(pidx + (size_t)tokbase * 128) + F.tid + 512 * q);
#pragma unroll
      for (int q = 0; q < 8; ++q) { const int i4 = F.tid + 512 * q, tl = i4 >> 5, k = (i4 & 31) * 4; *(LAS v4u*)(IDX + tl * 128 + ((k + 4 * (tl & 7)) & 127)) = tmp[q]; } }
    __syncthreads();
    const int skew = 4 * g;
    {
        v4u ub[PFU];
        { const int tl0 = wave * 8 + g; LAS const int* irow0 = IDX + tl0 * 128; const unsigned eo0 = (unsigned)(128 * (x & 7) + 16 * sub); unsigned idn[PFU];
#pragma unroll
          for (int j = 0; j < PFU / 4; ++j) { const v4u q = *(LAS const v4u*)(irow0 + ((4 * j + skew) & 127)); idn[4 * j] = q.x; idn[4 * j + 1] = q.y; idn[4 * j + 2] = q.z; idn[4 * j + 3] = q.w; }
#pragma unroll
          for (int i = 0; i < PFU; ++i) ub[i] = *(const GAS v4u*)(EU + ((idn[i] << 10) + eo0)); }
        v4u hreg = *(const GAS v4u*)(F.ws + WS_H8 + (size_t)(tokbase + wave * 8 + g) * D + 128 * (x & 7) + 16 * sub);
#pragma unroll 1
        for (int bi = 0; bi < 16; ++bi) {
            const int s = bi >> 1, sl = (x + s) & 7, tl = (bi & 1) * 64 + wave * 8 + g;
            const int bn = bi < 15 ? bi + 1 : 15, sln = (x + (bn >> 1)) & 7, tln = (bn & 1) * 64 + wave * 8 + g;
            const v4u hnext = *(const GAS v4u*)(F.ws + WS_H8 + (size_t)(tokbase + tln) * D + 128 * sln + 16 * sub);
            const unsigned eo = (unsigned)(128 * sl + 16 * sub), eon = (unsigned)(128 * sln + 16 * sub);
            LAS const int* irow = IDX + tl * 128; LAS const int* irown = IDX + tln * 128; LAS int* arow = AT + tl * 128;
#pragma unroll 1
            for (int k0 = 0; k0 < 128; k0 += PFU) {
                const bool lastc = (k0 + PFU >= 128);
                LAS const int* ir = lastc ? irown : irow; const int kn = lastc ? 0 : k0 + PFU; const unsigned eg = lastc ? eon : eo;
                unsigned idn[PFU];
#pragma unroll
                for (int j = 0; j < PFU / 4; ++j) { const v4u q = *(LAS const v4u*)(ir + ((kn + 4 * j + skew) & 127)); idn[4 * j] = q.x; idn[4 * j + 1] = q.y; idn[4 * j + 2] = q.z; idn[4 * j + 3] = q.w; }
                int coll[PFU / 8];
#pragma unroll
                for (int c = 0; c < PFU / 8; ++c) coll[c] = 0;
#pragma unroll
                for (int i = 0; i < PFU; ++i) {
                    int d = dot16(ub[i], hreg);
                    ub[i] = *(const GAS v4u*)(EU + ((idn[i] << 10) + eg));
                    d += dpp_i<0xB1>(d); d += dpp_i<0x4E>(d); d += dpp_i<0x141>(d);
                    coll[i >> 3] = (sub == (i & 7)) ? d : coll[i >> 3];
                }
#pragma unroll
                for (int c = 0; c < PFU / 8; ++c) { const int pos = (k0 + 8 * c + sub + skew) & 127; arow[pos] = (s == 0) ? coll[c] : arow[pos] + coll[c]; }
            }
            hreg = hnext;
        }
    }
    LDS_WAIT();
#pragma unroll 1
    for (int t4 = 0; t4 < 16; t4 += 2) {
        int e[2][2], pos[2][2]; float gv[2][2], suv[2][2], svv[2][2], hsv[2]; int av[2][2];
#pragma unroll
        for (int u = 0; u < 2; ++u) { const int tt = t4 + u, tl = (tt >> 3) * 64 + wave * 8 + (tt & 7), t = tokbase + tl; hsv[u] = HS[t];
#pragma unroll
            for (int hh = 0; hh < 2; ++hh) { const int k = hh * 64 + lane; pos[u][hh] = tl * 128 + ((k + 4 * (tl & 7)) & 127); e[u][hh] = IDX[pos[u][hh]]; av[u][hh] = AT[pos[u][hh]]; gv[u][hh] = pgate[(size_t)t * 128 + k]; } }
#pragma unroll
        for (int u = 0; u < 2; ++u)
#pragma unroll
            for (int hh = 0; hh < 2; ++hh) { const f32x2 s2 = SUV[e[u][hh]]; suv[u][hh] = s2.x; svv[u][hh] = s2.y; }
        LDS_WAIT();
#pragma unroll
        for (int u = 0; u < 2; ++u) { const int tt = t4 + u, tl = (tt >> 3) * 64 + wave * 8 + (tt & 7); float w[2];
#pragma unroll
            for (int hh = 0; hh < 2; ++hh) { const float af = (float)av[u][hh] * suv[u][hh] * hsv[u];
                w[hh] = gv[u][hh] * 0.5f * af * (1.f + erff(af * 0.70710678118654752f)) * svv[u][hh]; }
            const float wmax = wave_max_fast(fmaxf(fabsf(w[0]), fabsf(w[1])));
            const float inv = wmax > 0.f ? 127.f / wmax : 0.f;
            LAS signed char* wq = (LAS signed char*)(AT + tl * 128);
#pragma unroll
            for (int hh = 0; hh < 2; ++hh) wq[(hh * 64 + lane + 16 * (tl & 7)) & 127] = (signed char)(int)rintf(w[hh] * inv);
            if (lane == 0) WT[tl] = wmax * (1.f / 127.f); }
    }
    LDS_WAIT();
    float ssq0 = 0.f, ssq1 = 0.f;
    {
        v4u ub[PFV];
        { const int tl0 = wave * 8 + g; LAS const int* irow0 = IDX + tl0 * 128; const unsigned eo0 = (unsigned)(128 * (x & 7) + 16 * sub); unsigned idn[PFV];
#pragma unroll
          for (int j = 0; j < PFV / 4; ++j) { const v4u q = *(LAS const v4u*)(irow0 + ((4 * j + skew) & 127)); idn[4 * j] = q.x; idn[4 * j + 1] = q.y; idn[4 * j + 2] = q.z; idn[4 * j + 3] = q.w; }
#pragma unroll
          for (int i = 0; i < PFV; ++i) ub[i] = *(const GAS v4u*)(EV + ((idn[i] << 10) + eo0)); }
#pragma unroll 1
        for (int bi = 0; bi < 16; ++bi) {
            const int s = bi >> 1, sl = (x + s) & 7, rd = bi & 1, tl = rd * 64 + wave * 8 + g, t = tokbase + tl;
            const int bn = bi < 15 ? bi + 1 : 15, sln = (x + (bn >> 1)) & 7, tln = (bn & 1) * 64 + wave * 8 + g;
            const unsigned eo = (unsigned)(128 * sl + 16 * sub), eon = (unsigned)(128 * sln + 16 * sub);
            LAS const int* irow = IDX + tl * 128; LAS const int* irown = IDX + tln * 128; LAS const unsigned char* wrow = (LAS const unsigned char*)(AT + tl * 128);
            int acc[16];
#pragma unroll
            for (int i = 0; i < 16; ++i) acc[i] = 0;
#pragma unroll 1
            for (int k0 = 0; k0 < 128; k0 += PFV) {
                const bool lastc = (k0 + PFV >= 128);
                LAS const int* ir = lastc ? irown : irow; const int kn = lastc ? 0 : k0 + PFV; const unsigned eg = lastc ? eon : eo;
                unsigned idn[PFV];
#pragma unroll
                for (int j = 0; j < PFV / 4; ++j) { const v4u q = *(LAS const v4u*)(ir + ((kn + 4 * j + skew) & 127)); idn[4 * j] = q.x; idn[4 * j + 1] = q.y; idn[4 * j + 2] = q.z; idn[4 * j + 3] = q.w; }
                const v2u wq2 = *(LAS const v2u*)(wrow + ((k0 + 16 * g) & 127));
                const unsigned wqa[2] = {wq2.x, wq2.y};
#pragma unroll
                for (int j = 0; j < PFV / 4; ++j) {
                    const v4u r0 = ub[4 * j], r1 = ub[4 * j + 1], r2 = ub[4 * j + 2], r3 = ub[4 * j + 3];
#pragma unroll
                    for (int i = 0; i < 4; ++i) ub[4 * j + i] = *(const GAS v4u*)(EV + ((idn[4 * j + i] << 10) + eg));
                    const unsigned c0[4] = {r0.x, r0.y, r0.z, r0.w}, c1[4] = {r1.x, r1.y, r1.z, r1.w}, c2[4] = {r2.x, r2.y, r2.z, r2.w}, c3[4] = {r3.x, r3.y, r3.z, r3.w};
#pragma unroll
                    for (int q = 0; q < 4; ++q) {
                        const unsigned lo01 = __builtin_amdgcn_perm(c1[q], c0[q], 0x05010400u), hi01 = __builtin_amdgcn_perm(c1[q], c0[q], 0x07030602u);
                        const unsigned lo23 = __builtin_amdgcn_perm(c3[q], c2[q], 0x05010400u), hi23 = __builtin_amdgcn_perm(c3[q], c2[q], 0x07030602u);
                        const unsigned t0 = __builtin_amdgcn_perm(lo23, lo01, 0x05040100u), t1 = __builtin_amdgcn_perm(lo23, lo01, 0x07060302u);
                        const unsigned t2 = __builtin_amdgcn_perm(hi23, hi01, 0x05040100u), t3 = __builtin_amdgcn_perm(hi23, hi01, 0x07060302u);
                        acc[4 * q] = __builtin_amdgcn_sdot4((int)t0, (int)wqa[j], acc[4 * q], false);
                        acc[4 * q + 1] = __builtin_amdgcn_sdot4((int)t1, (int)wqa[j], acc[4 * q + 1], false);
                        acc[4 * q + 2] = __builtin_amdgcn_sdot4((int)t2, (int)wqa[j], acc[4 * q + 2], false);
                        acc[4 * q + 3] = __builtin_amdgcn_sdot4((int)t3, (int)wqa[j], acc[4 * q + 3], false);
                    }
                }
            }
            const float sc = WT[tl]; float y[16]; float sq = 0.f;
#pragma unroll
            for (int i = 0; i < 16; ++i) { y[i] = (float)acc[i] * sc; sq += y[i] * y[i]; }
            ssq0 += rd ? 0.f : sq; ssq1 += rd ? sq : 0.f;
            bf16* yp = Y2 + (size_t)t * D + 128 * sl + 16 * sub;
#pragma unroll
            for (int q8 = 0; q8 < 2; ++q8) __builtin_nontemporal_store((v4u){pk2(y[8 * q8], y[8 * q8 + 1]), pk2(y[8 * q8 + 2], y[8 * q8 + 3]), pk2(y[8 * q8 + 4], y[8 * q8 + 5]), pk2(y[8 * q8 + 6], y[8 * q8 + 7])}, (v4u*)(yp + 8 * q8));
        }
    }
#pragma unroll
    for (int rd = 0; rd < 2; ++rd) { float v = rd ? ssq1 : ssq0; v += dpp_f<0xB1>(v); v += dpp_f<0x4E>(v); v += dpp_f<0x141>(v); if (sub == 0) WT[rd * 64 + wave * 8 + g] = v; }
    asm volatile("s_waitcnt vmcnt(0) lgkmcnt(0)" ::: "memory");
    const float* mod = (const float*)(F.ws + WS_MOD); const float* gp1 = F.in[I_GPOST1]; const float* gp2 = F.in[I_GPOST2];
    const float* R1 = (const float*)(F.ws + WS_R1); const bf16* Y1 = (const bf16*)(F.ws + WS_Y);
    f32x4 q2[4];
    { const float* mb = mod + (tokbase / S) * NMOD;
#pragma unroll
      for (int j = 0; j < 4; ++j) { const int col = (lane + 64 * j) * 4; q2[j] = *(const f32x4*)(mb + 5 * D + col) * *(const f32x4*)(gp2 + col); } }
    const bf16* X1 = (const bf16*)(F.ws + WS_X1B);
#pragma unroll 1
    for (int t2 = 0; t2 < 16; t2 += 4) {
        v2u xv[4][4], zv[4][4];
#pragma unroll
        for (int u = 0; u < 4; ++u) { const int tt = t2 + u, tl = (tt >> 3) * 64 + wave * 8 + (tt & 7), m = tokbase + tl;
#pragma unroll
            for (int j = 0; j < 4; ++j) { xv[u][j] = __builtin_nontemporal_load((const GAS v2u*)(X1 + (size_t)m * D) + lane + 64 * j);
                zv[u][j] = __builtin_nontemporal_load((const GAS v2u*)(Y2 + (size_t)m * D) + lane + 64 * j); } }
#pragma unroll
        for (int u = 0; u < 4; ++u) { const int tt = t2 + u, tl = (tt >> 3) * 64 + wave * 8 + (tt & 7), m = tokbase + tl;
            const float r2 = rsqrtf(WT[tl] * (1.f / D) + EPS);
#pragma unroll
            for (int j = 0; j < 4; ++j) {
                const f32x4 x1 = (f32x4){bflo(xv[u][j].x), bfhi(xv[u][j].x), bflo(xv[u][j].y), bfhi(xv[u][j].y)};
                const f32x4 y2 = (f32x4){bflo(zv[u][j].x), bfhi(zv[u][j].x), bflo(zv[u][j].y), bfhi(zv[u][j].y)};
                __builtin_nontemporal_store(x1 + q2[j] * y2 * r2, (GAS f32x4*)(F.out + (size_t)m * D) + lane + 64 * j); } }
    }
    __syncthreads();
}
}
struct Args { const float* in[18]; float* out; unsigned char* ws; int ph_lo, ph_hi; };
__global__ void __launch_bounds__(NWAVES * 64, 2) mega(Args args) {
    extern __shared__ __attribute__((aligned(16))) unsigned char lds[];
    Frame F;
    F.lds = (LAS unsigned char*)lds;
    F.MISC = (volatile LAS unsigned*)(F.lds + MISC_OFF);
    F.tid = threadIdx.x; F.lane = F.tid & 63; F.wave = __builtin_amdgcn_readfirstlane(F.tid >> 6);
    F.G = gridDim.x; { const int bx = blockIdx.x; F.vcu = (F.G % 8 == 0) ? (bx % 8) * (F.G / 8) + bx / 8 : bx; }
    F.in = args.in; F.out = args.out; F.ws = args.ws;
    F.ctl = (gu32*)(args.ws + WS_CTL);
    for (int u = F.tid; u < (LDS_BYTES - LDSCTL_OFF) / 4; u += NWAVES * 64) ((LAS unsigned*)(F.lds + LDSCTL_OFF))[u] = 0u;
    __syncthreads();
    const int lo = args.ph_lo, hi = args.ph_hi;
    const bool fused = (hi - lo) > 1;
    XcdBarrier bar; bar.bar = (unsigned*)(F.ctl + CW_BAR); bar.x = 0; bar.st = nullptr;
    if (fused) bar = xcd_barrier_post((unsigned*)(F.ctl + CW_BAR), F.MISC + 8);
#define IN(k) (lo <= (k) && (k) < hi)
#define SEAM(k) do { if (IN(k) && IN((k) + 1)) xcd_barrier(bar); } while (0)
    if (IN(0)) { p0a(F); SEAM(0); }
    if (IN(1)) { p0b(F); SEAM(1); }
    if (IN(2)) {
        pg8::Gemm g{(const bf16*)(F.ws + WS_H), (const bf16*)(F.ws + WS_WIN), T, INC, D / 2};
        pg8::StaticOrder So; So.init(T, INC, F.G, (int)blockIdx.x);
        __builtin_amdgcn_global_load_lds((const unsigned*)((const float*)(F.ws + WS_MISC) + 64 + F.tid), (LAS unsigned*)(F.lds + pg8::SCL_OFF + 4096 + F.wave * 256), 4, 0, 0);
        EpiProj E{(bf16*)(F.ws + WS_P), (float*)(F.ws + WS_HD), (const LAS float*)(F.lds + pg8::SCL_OFF + 4096), (const float*)(F.ws + WS_RS), (const float*)(F.ws + WS_CS)};
        pg8::gemm_phase<EpiProj, pg8::StaticOrder, true, true, true>(F.lds + RING_OFF, g, So, E);
        SEAM(2);
    }
    if (IN(3)) { hgrn::pass_a(F); SEAM(3); }
    if (IN(4)) { attn::attn_phase(F); hgrn::pass_c(F); SEAM(4); }
    if (IN(5)) {
        pg8::Gemm g{(const bf16*)(F.ws + WS_CAT), (const bf16*)(F.ws + WS_WOUT), T, D, D};
        pg8::StaticOrder So; So.init(T, D, F.G, (int)blockIdx.x);
        EpiBf16 E{(bf16*)(F.ws + WS_Y), D};
        pg8::gemm_phase<EpiBf16, pg8::StaticOrder, true, true>(F.lds + RING_OFF, g, So, E);
        SEAM(5);
    }
    if (IN(6)) { p_mid(F); SEAM(6); }
    if (IN(7)) {
        pg8::Gemm g{(const bf16*)(F.ws + WS_H8), (const bf16*)(F.ws + WS_WPQ), T, NPQ, D / 2};
        pg8::StaticOrder So; So.init(T, NPQ, F.G, (int)blockIdx.x);
        EpiBf16I8 E{(bf16*)(F.ws + WS_Q), NPQ, (const float*)(F.ws + WS_HS), (const float*)(F.ws + WS_CS2)};
        pg8::gemm_phase<EpiBf16I8, pg8::StaticOrder, true, true, true>(F.lds + RING_OFF, g, So, E);
        SEAM(7);
    }
    if (IN(8)) { topk::phase(F); SEAM(8); }
    if (IN(9)) { peer::phase(F); }
#undef IN
#undef SEAM
}
extern "C" void kernel_launch(void* const* d_in, const int* in_sizes, int n_in, void* d_out, int out_size, void* d_ws, size_t ws_size, hipStream_t stream) {
    static int grid = 0;
    if (grid == 0) {
        if (n_in != 18 || ws_size < WS_END) { fprintf(stderr, "kernel_launch: unexpected n_in %d / ws %zu\n", n_in, ws_size); grid = -1; return; }
        int dev = 0, cus = 0;
        if (hipGetDevice(&dev) != hipSuccess || hipDeviceGetAttribute(&cus, hipDeviceAttributeMultiprocessorCount, dev) != hipSuccess) { grid = -1; return; }
        if (hipFuncSetAttribute((const void*)mega, hipFuncAttributeMaxDynamicSharedMemorySize, LDS_BYTES) != hipSuccess) { fprintf(stderr, "hipFuncSetAttribute failed\n"); grid = -1; return; }
        grid = 256; (void)cus;
    }
    if (grid < 0) return;
    (void)hipMemsetAsync((char*)d_ws + WS_CTL, 0, CTL_ZERO_BYTES, stream);
    Args a{};
    for (int i = 0; i < 18; ++i) a.in[i] = (const float*)d_in[i];
    a.out = (float*)d_out; a.ws = (unsigned char*)d_ws;
    a.ph_lo = 0; a.ph_hi = 10;
    hipLaunchKernelGGL(mega, dim3(grid), dim3(NWAVES * 64), LDS_BYTES, stream, a);
}
```
